# Optimizing an MI355X kernel written in HIP

```python
import math
import jax, jax.numpy as jnp
from jax import lax
import numpy as np

D_MODEL = 1024
BATCH = 4
SEQ = 4096
DEPTH = 4

CHUNK = 64
N_MIXERS = 3
EPS = 1e-6

ML_HEADS = 4
ML_DQK = 128
ML_DV = D_MODEL // ML_HEADS
ML_CONV = 4
ML_QK_W = 2 * ML_HEADS * ML_DQK
ML_IN_W = ML_QK_W + 2 * D_MODEL + 2 * ML_HEADS

AT_HEADS = 16
AT_DH = D_MODEL // AT_HEADS
AT_LEFT_CHUNKS = 8
AT_BAND = (AT_LEFT_CHUNKS + 1) * CHUNK
MAX_REL = 128

S5_GROUP = 16
S5_GROUPS = D_MODEL // S5_GROUP
S5_STATE = 64

DFF_DENSE = 2816
N_EXPERTS = 8
TOP_K = 2
DFF_EXPERT = 3584

N_ML_LAYERS = (DEPTH + 2) // 3
N_AT_LAYERS = (DEPTH + 1) // 3
N_S5_LAYERS = DEPTH // 3
N_DENSE_LAYERS = (DEPTH + 1) // 2
N_MOE_LAYERS = DEPTH // 2

kernel_name = 'hybrid_chunk_causal_encoder'


def rmsnorm(x, g):
    xf = x.astype(jnp.float32)
    inv = lax.rsqrt(jnp.mean(xf * xf, axis=-1, keepdims=True) + EPS)
    return (xf * inv).astype(x.dtype) * g


def causal_dwconv(x, w):
    k = w.shape[0]
    s = x.shape[1]
    xp = jnp.pad(x, ((0, 0), (k - 1, 0), (0, 0)))
    return sum(xp[:, j:j + s] * w[j] for j in range(k))


def mlstm_chunk_step(carry, inp):
    c_prev, n_prev, m_prev = carry
    q, k, v, ig, lf = inp
    L = q.shape[2]
    b = jnp.cumsum(lf, axis=-1)
    causal = jnp.tril(jnp.ones((L, L), dtype=bool))
    logd = jnp.where(causal, b[..., :, None] - b[..., None, :] + ig[..., None, :], -jnp.inf)
    inter = b + m_prev[..., None]
    m_t = jnp.maximum(inter, jnp.max(logd, axis=-1))
    w = jnp.exp(logd - m_t[..., None])
    s = jnp.einsum('bhtd,bhsd->bhts', q, k) * w
    w_inter = jnp.exp(inter - m_t)
    num = jnp.einsum('bhts,bhsv->bhtv', s, v) + w_inter[..., None] * jnp.einsum('bhtd,bhdv->bhtv', q, c_prev)
    den = jnp.sum(s, axis=-1) + w_inter * jnp.einsum('bhtd,bhd->bht', q, n_prev)
    h = num / jnp.maximum(jnp.abs(den), jnp.exp(-m_t))[..., None]
    b_last = b[..., -1]
    logw = b_last[..., None] - b + ig
    m_new = jnp.maximum(b_last + m_prev, jnp.max(logw, axis=-1))
    decay = jnp.exp(b_last + m_prev - m_new)
    wk = jnp.exp(logw - m_new[..., None])
    c_new = decay[..., None, None] * c_prev + jnp.einsum('bhs,bhsd,bhsv->bhdv', wk, k, v)
    n_new = decay[..., None] * n_prev + jnp.einsum('bhs,bhsd->bhd', wk, k)
    return (c_new, n_new, m_new), h


def mlstm_mixer(h, w_in, b_if, conv_w, head_gain, w_out):
    B, S, _ = h.shape
    nc = S // CHUNK
    f32 = jnp.float32
    proj = h @ w_in
    qk = jax.nn.silu(causal_dwconv(proj[..., :ML_QK_W], conv_w))
    v = proj[..., ML_QK_W:ML_QK_W + D_MODEL]
    o = proj[..., ML_QK_W + D_MODEL:ML_QK_W + 2 * D_MODEL]
    gates = proj[..., ML_QK_W + 2 * D_MODEL:].astype(f32).reshape(B, S, 2, ML_HEADS) + b_if.astype(f32)
    ig = gates[:, :, 0]
    lf = jax.nn.log_sigmoid(gates[:, :, 1])
    q = qk[..., :ML_HEADS * ML_DQK].reshape(B, S, ML_HEADS, ML_DQK)
    k = qk[..., ML_HEADS * ML_DQK:].reshape(B, S, ML_HEADS, ML_DQK) * (ML_DQK ** -0.5)
    v = v.reshape(B, S, ML_HEADS, ML_DV)

    def to_chunks(t):
        return t.astype(f32).reshape(B, nc, CHUNK, ML_HEADS, -1).transpose(1, 0, 3, 2, 4)

    def gate_chunks(t):
        return t.reshape(B, nc, CHUNK, ML_HEADS).transpose(1, 0, 3, 2)

    init = (jnp.zeros((B, ML_HEADS, ML_DQK, ML_DV), f32),
            jnp.zeros((B, ML_HEADS, ML_DQK), f32),
            jnp.zeros((B, ML_HEADS), f32))
    _, hs = lax.scan(mlstm_chunk_step, init,
                     (to_chunks(q), to_chunks(k), to_chunks(v), gate_chunks(ig), gate_chunks(lf)))
    hs = hs.transpose(1, 0, 3, 2, 4).reshape(B, S, ML_HEADS, ML_DV)
    hs = hs * lax.rsqrt(jnp.mean(hs * hs, axis=-1, keepdims=True) + EPS)
    hs = (hs.reshape(B, S, D_MODEL) * head_gain).astype(h.dtype)
    return (hs * jax.nn.sigmoid(o)) @ w_out


def chunk_attention(h, w_in, rel_bias, w_out):
    B, S, _ = h.shape
    nc = S // CHUNK
    pad = AT_LEFT_CHUNKS * CHUNK
    qkv = (h @ w_in).reshape(B, S, 3, AT_HEADS, AT_DH)
    q = qkv[:, :, 0] * (AT_DH ** -0.5)
    kp = jnp.pad(qkv[:, :, 1], ((0, 0), (pad, 0), (0, 0), (0, 0)))
    vp = jnp.pad(qkv[:, :, 2], ((0, 0), (pad, 0), (0, 0), (0, 0)))
    rel = (jnp.arange(AT_BAND) - pad)[None, :] - jnp.arange(CHUNK)[:, None]
    bias = rel_bias[:, jnp.clip(rel, -MAX_REL, MAX_REL) + MAX_REL].astype(jnp.float32)
    qc = q.reshape(B, nc, CHUNK, AT_HEADS, AT_DH).transpose(1, 0, 2, 3, 4)

    def one_chunk(args):
        q_c, c = args
        start = c * CHUNK
        k_b = lax.dynamic_slice_in_dim(kp, start, AT_BAND, axis=1)
        v_b = lax.dynamic_slice_in_dim(vp, start, AT_BAND, axis=1)
        key_pos = start - pad + jnp.arange(AT_BAND)
        s = jnp.einsum('bqhd,bkhd->bhqk', q_c, k_b).astype(jnp.float32) + bias
        s = jnp.where(key_pos >= 0, s, -jnp.inf)
        p = jax.nn.softmax(s, axis=-1).astype(v_b.dtype)
        return jnp.einsum('bhqk,bkhd->bqhd', p, v_b)

    o = lax.map(one_chunk, (qc, jnp.arange(nc)))
    o = o.transpose(1, 0, 2, 3, 4).reshape(B, S, D_MODEL)
    return o @ w_out


def _complex_affine_combine(e1, e2):
    a1r, a1i, b1r, b1i = e1
    a2r, a2i, b2r, b2i = e2
    return (a2r * a1r - a2i * a1i,
            a2r * a1i + a2i * a1r,
            a2r * b1r - a2i * b1i + b2r,
            a2r * b1i + a2i * b1r + b2i)


def s5_mixer(h, w_in, lam_re, lam_im, log_dt, b_re, b_im, c_re, c_im, d_skip, w_out):
    B, S, _ = h.shape
    f32 = jnp.float32
    u = (h @ w_in).astype(f32)
    ug = u.reshape(B, S, S5_GROUPS, S5_GROUP)
    lr = lam_re.astype(f32)
    li = lam_im.astype(f32)
    dt = jnp.exp(log_dt.astype(f32))[:, None]
    mag = jnp.exp(lr * dt)
    ang = li * dt
    ab_re = mag * jnp.cos(ang)
    ab_im = mag * jnp.sin(ang)
    den = lr * lr + li * li
    nr = ab_re - 1.0
    z_re = (nr * lr + ab_im * li) / den
    z_im = (ab_im * lr - nr * li) / den
    bb_re = z_re[..., None] * b_re - z_im[..., None] * b_im
    bb_im = z_re[..., None] * b_im + z_im[..., None] * b_re
    bu_re = jnp.einsum('bsgp,gnp->sbgn', ug, bb_re)
    bu_im = jnp.einsum('bsgp,gnp->sbgn', ug, bb_im)
    a_re = jnp.broadcast_to(ab_re[None, None], (S, 1, S5_GROUPS, S5_STATE))
    a_im = jnp.broadcast_to(ab_im[None, None], (S, 1, S5_GROUPS, S5_STATE))
    _, _, x_re, x_im = lax.associative_scan(_complex_affine_combine, (a_re, a_im, bu_re, bu_im), axis=0)
    y = jnp.einsum('sbgn,gpn->bsgp', x_re, c_re) - jnp.einsum('sbgn,gpn->bsgp', x_im, c_im)
    y = y.reshape(B, S, D_MODEL) + d_skip * u
    y = jax.nn.gelu(y).astype(h.dtype)
    z = y @ w_out
    return z[..., :D_MODEL] * jax.nn.sigmoid(z[..., D_MODEL:])


def swiglu(t, wg, wu, wd):
    return (jax.nn.silu(t @ wg) * (t @ wu)) @ wd


def moe_ffn(h, router, router_b, wg, wu, wd):
    B, S, dm = h.shape
    t = h.reshape(-1, dm)
    logits = (t @ router).astype(jnp.float32) + router_b.astype(jnp.float32)
    top_vals, top_idx = lax.top_k(logits, TOP_K)
    top_w = jax.nn.softmax(top_vals, axis=-1)
    gates = jnp.sum(jax.nn.one_hot(top_idx, N_EXPERTS, dtype=jnp.float32) * top_w[..., None], axis=1)
    gates = gates.astype(t.dtype)
    out = jnp.zeros_like(t)
    for e in range(N_EXPERTS):
        out = out + gates[:, e:e + 1] * swiglu(t, wg[e], wu[e], wd[e])
    return out.reshape(B, S, dm)


def setup_inputs(seed: int = 0) -> dict:
    key = jax.random.key(seed)
    ks = jax.random.split(key, 32)
    f32 = jnp.float32

    def nrm(k, shape, scale):
        return scale * jax.random.normal(k, shape, f32)

    D = D_MODEL
    x = nrm(ks[0], (BATCH, SEQ, D), 1.0)
    norm_mix = 1.0 + nrm(ks[1], (DEPTH, D), 0.02)
    norm_ffn = 1.0 + nrm(ks[2], (DEPTH, D), 0.02)
    norm_final = 1.0 + nrm(ks[3], (D,), 0.02)

    ml_w_in = nrm(ks[4], (N_ML_LAYERS, D, ML_IN_W), D ** -0.5)
    ig_b = nrm(ks[5], (N_ML_LAYERS, 1, ML_HEADS), 0.1)
    fg_b = jnp.linspace(3.0, 6.0, ML_HEADS, dtype=f32)[None, None, :] + nrm(ks[6], (N_ML_LAYERS, 1, ML_HEADS), 0.1)
    ml_b_if = jnp.concatenate([ig_b, fg_b], axis=1)
    ml_conv_w = nrm(ks[7], (N_ML_LAYERS, ML_CONV, ML_QK_W), ML_CONV ** -0.5)
    ml_head_gain = 1.0 + nrm(ks[8], (N_ML_LAYERS, D), 0.02)
    ml_w_out = nrm(ks[9], (N_ML_LAYERS, D, D), D ** -0.5)

    at_w_in = nrm(ks[10], (N_AT_LAYERS, D, 3 * D), D ** -0.5)
    at_rel_bias = nrm(ks[11], (N_AT_LAYERS, AT_HEADS, 2 * MAX_REL + 1), 0.5)
    at_w_out = nrm(ks[12], (N_AT_LAYERS, D, D), D ** -0.5)

    s5_w_in = nrm(ks[13], (N_S5_LAYERS, D, D), D ** -0.5)
    s5_lambda_re = -0.5 + nrm(ks[14], (N_S5_LAYERS, S5_GROUPS, S5_STATE), 0.02)
    s5_lambda_im = math.pi * jnp.arange(S5_STATE, dtype=f32)[None, None, :] + nrm(ks[15], (N_S5_LAYERS, S5_GROUPS, S5_STATE), 0.02)
    s5_log_dt = jax.random.uniform(ks[16], (N_S5_LAYERS, S5_GROUPS), f32, math.log(0.001), math.log(0.1))
    s5_b_re = nrm(ks[17], (N_S5_LAYERS, S5_GROUPS, S5_STATE, S5_GROUP), (2 * S5_GROUP) ** -0.5)
    s5_b_im = nrm(ks[18], (N_S5_LAYERS, S5_GROUPS, S5_STATE, S5_GROUP), (2 * S5_GROUP) ** -0.5)
    s5_c_re = nrm(ks[19], (N_S5_LAYERS, S5_GROUPS, S5_GROUP, S5_STATE), (2 * S5_STATE) ** -0.5)
    s5_c_im = nrm(ks[20], (N_S5_LAYERS, S5_GROUPS, S5_GROUP, S5_STATE), (2 * S5_STATE) ** -0.5)
    s5_d = nrm(ks[21], (N_S5_LAYERS, D), 1.0)
    s5_w_out = nrm(ks[22], (N_S5_LAYERS, D, 2 * D), D ** -0.5)

    ff_w_gate = nrm(ks[23], (N_DENSE_LAYERS, D, DFF_DENSE), D ** -0.5)
    ff_w_up = nrm(ks[24], (N_DENSE_LAYERS, D, DFF_DENSE), D ** -0.5)
    ff_w_down = nrm(ks[25], (N_DENSE_LAYERS, DFF_DENSE, D), DFF_DENSE ** -0.5)

    moe_router = nrm(ks[26], (N_MOE_LAYERS, D, N_EXPERTS), D ** -0.5)
    moe_router_b = nrm(ks[27], (N_MOE_LAYERS, N_EXPERTS), 0.01)
    moe_w_gate = nrm(ks[28], (N_MOE_LAYERS, N_EXPERTS, D, DFF_EXPERT), D ** -0.5)
    moe_w_up = nrm(ks[29], (N_MOE_LAYERS, N_EXPERTS, D, DFF_EXPERT), D ** -0.5)
    moe_w_down = nrm(ks[30], (N_MOE_LAYERS, N_EXPERTS, DFF_EXPERT, D), DFF_EXPERT ** -0.5)

    return {'x': x, 'norm_mix': norm_mix, 'norm_ffn': norm_ffn, 'norm_final': norm_final,
            'ml_w_in': ml_w_in, 'ml_b_if': ml_b_if, 'ml_conv_w': ml_conv_w,
            'ml_head_gain': ml_head_gain, 'ml_w_out': ml_w_out,
            'at_w_in': at_w_in, 'at_rel_bias': at_rel_bias, 'at_w_out': at_w_out,
            's5_w_in': s5_w_in, 's5_lambda_re': s5_lambda_re, 's5_lambda_im': s5_lambda_im,
            's5_log_dt': s5_log_dt, 's5_b_re': s5_b_re, 's5_b_im': s5_b_im,
            's5_c_re': s5_c_re, 's5_c_im': s5_c_im, 's5_d': s5_d, 's5_w_out': s5_w_out,
            'ff_w_gate': ff_w_gate, 'ff_w_up': ff_w_up, 'ff_w_down': ff_w_down,
            'moe_router': moe_router, 'moe_router_b': moe_router_b,
            'moe_w_gate': moe_w_gate, 'moe_w_up': moe_w_up, 'moe_w_down': moe_w_down}


def reference(x, norm_mix, norm_ffn, norm_final,
              ml_w_in, ml_b_if, ml_conv_w, ml_head_gain, ml_w_out,
              at_w_in, at_rel_bias, at_w_out,
              s5_w_in, s5_lambda_re, s5_lambda_im, s5_log_dt, s5_b_re, s5_b_im,
              s5_c_re, s5_c_im, s5_d, s5_w_out,
              ff_w_gate, ff_w_up, ff_w_down,
              moe_router, moe_router_b, moe_w_gate, moe_w_up, moe_w_down):
    for i in range(DEPTH):
        kind = i % N_MIXERS
        j = i // N_MIXERS
        hn = rmsnorm(x, norm_mix[i])
        if kind == 0:
            mix = mlstm_mixer(hn, ml_w_in[j], ml_b_if[j], ml_conv_w[j], ml_head_gain[j], ml_w_out[j])
        elif kind == 1:
            mix = chunk_attention(hn, at_w_in[j], at_rel_bias[j], at_w_out[j])
        else:
            mix = s5_mixer(hn, s5_w_in[j], s5_lambda_re[j], s5_lambda_im[j], s5_log_dt[j],
                           s5_b_re[j], s5_b_im[j], s5_c_re[j], s5_c_im[j], s5_d[j], s5_w_out[j])
        x = x + mix
        hn = rmsnorm(x, norm_ffn[i])
        f = i // 2
        if i % 2 == 0:
            x = x + swiglu(hn, ff_w_gate[f], ff_w_up[f], ff_w_down[f])
        else:
            x = x + moe_ffn(hn, moe_router[f], moe_router_b[f], moe_w_gate[f], moe_w_up[f], moe_w_down[f])
    return rmsnorm(x, norm_final)
```

```cpp
#include <hip/hip_runtime.h>
#include <cstdio>
#include <cstdint>
namespace pg8 {
#define PG8_LAS __attribute__((address_space(3)))
typedef unsigned short bf16_t;
typedef short bf16x8 __attribute__((ext_vector_type(8)));
typedef float f32x4 __attribute__((ext_vector_type(4)));
typedef unsigned u32x4 __attribute__((ext_vector_type(4)));
constexpr int BM = 256, BK = 64, HALF = 128, HTB = HALF * BK * 2  , STAGE_BYTES = 8 * HTB, NXCD = 8, WGM = 4;

__host__ __device__ __forceinline__ int lds_byte(int r, int c) { const int st = (r >> 4) * 2 + (c >> 5), rr = r & 15, cc = c & 31, ob = rr * 64 + cc * 2; return st * 1024 + (ob ^ (((ob >> 9) & 1) << 5)); }
__host__ __device__ __forceinline__ void stage_rc(int b, int& R, int& C) { const int st = b / 1024, sb = b % 1024, swz = sb ^ (((sb >> 9) & 1) << 5); R = (st >> 1) * 16 + swz / 64; C = (st & 1) * 32 + (swz % 64) / 2; }
__host__ __device__ __forceinline__ int perm32(int rho) { const int n = rho >> 4, i = rho & 15; return 8 * (i >> 2) + 4 * n + (i & 3); }

struct Unit { int pm, pn, e; };
struct Gemm { const bf16_t* A; const bf16_t* Bt; int M, N, K; size_t bstride; int wave; unsigned a_rs = 0, a_ps = 0; };
__device__ __forceinline__ int lane_asm() { int l; asm volatile("v_mbcnt_lo_u32_b32 %0, -1, 0\n\tv_mbcnt_hi_u32_b32 %0, -1, %0" : "=v"(l)); return l; }


struct StaticOrder {
    int nM, nN, nwg, G, c;
    __host__ __device__ void init(int M, int N, int G_, int c_) { nM = M / BM; nN = N / BM; nwg = nM * nN; G = G_; c = c_; }
    __host__ __device__ bool next(int i, Unit& u) const {
        const long L = (long)i * G + c; if (L >= nwg) return false;
        int wgid = (int)L; { const int q = nwg / NXCD, r = nwg % NXCD, xcd = wgid % NXCD, off = wgid / NXCD; wgid = (xcd < r ? xcd * (q + 1) : r * (q + 1) + (xcd - r) * q) + off; }
        const int nig = WGM * nN, gid = wgid / nig, fm = gid * WGM, gsz = (nM - fm) < WGM ? (nM - fm) : WGM;
        u.pm = fm + ((wgid % nig) % gsz); u.pn = (wgid % nig) / gsz; u.e = 0; return true;
    }
    __device__ __forceinline__ void a_ready(const Unit&) const {}
    __device__ __forceinline__ void done(const Unit&) const {}
};
struct MoeOrder {
    const PG8_LAS int* panel_e; int npanels, nN, G, c;
    __device__ __forceinline__ bool next(int i, Unit& u) const {
        const int ngrp = nN >> 2, st = i * 8 + (c & 7), r = c >> 3;
        const int pg = (int)((unsigned)st / (unsigned)ngrp), ng = st - pg * ngrp;
        u.pm = pg * 8 + (r & 7); u.pn = ng * 4 + (r >> 3);
        if (u.pm >= npanels) return false;
        u.e = __builtin_amdgcn_readfirstlane(panel_e[u.pm]); return true;
    }
    __device__ __forceinline__ void a_ready(const Unit&) const {}
    __device__ __forceinline__ void done(const Unit&) const {}
};

__device__ __forceinline__ unsigned cvt_pk_bf16(float lo, float hi) { unsigned r; asm volatile("v_cvt_pk_bf16_f32 %0, %1, %2" : "=v"(r) : "v"(lo), "v"(hi)); return r; }

template <int NSLOT> __device__ __forceinline__ float row_inv(const float* ssqp, int row, int fq) {
    const float* p = ssqp + (size_t)row * NSLOT + (NSLOT / 4) * fq; float s;
    if constexpr (NSLOT == 16) { const f32x4 a = *(const f32x4*)p; s = (a.x + a.y) + (a.z + a.w); }
    else { const f32x4 a = *(const f32x4*)p, b = *(const f32x4*)(p + 4); s = ((a.x + a.y) + (a.z + a.w)) + ((b.x + b.y) + (b.z + b.w)); }
    s += __shfl_xor(s, 16); s += __shfl_xor(s, 32);
    return rsqrtf(s * (1.f / 1024.f) + 1e-6f);
}
template <int NSLOT> __device__ __forceinline__ void row_inv8(const float* ssqp, int row0, int fq, float (&inv)[2][4]) {
    float s[2][4];
#pragma unroll
    for (int ai = 0; ai < 2; ++ai)
#pragma unroll
        for (int m = 0; m < 4; ++m) { const float* p = ssqp + (size_t)(row0 + ai * HALF + m * 16) * NSLOT + (NSLOT / 4) * fq;
            if constexpr (NSLOT == 16) { const f32x4 a = *(const f32x4*)p; s[ai][m] = (a.x + a.y) + (a.z + a.w); }
            else { const f32x4 a = *(const f32x4*)p, b = *(const f32x4*)(p + 4); s[ai][m] = ((a.x + a.y) + (a.z + a.w)) + ((b.x + b.y) + (b.z + b.w)); } }
#pragma unroll
    for (int ai = 0; ai < 2; ++ai)
#pragma unroll
        for (int m = 0; m < 4; ++m) { float t = s[ai][m]; t += __shfl_xor(t, 16); t += __shfl_xor(t, 32); inv[ai][m] = rsqrtf(t * (1.f / 1024.f) + 1e-6f); }
}
template <int ROWINV = 0>
struct EpiBf16 {
    static constexpr bool PERM = true, AFTER_DRAIN = false;
    static constexpr int NST = 16;
    bf16_t* O; int ldc; int scale_cols; float scale0; const float* ssqp; float scale1 = 1.f;
    __device__ __forceinline__ void operator()(const f32x4 (&acc)[2][2][4][2], const Unit& u, int wr, int wc, int fr, int fq) const {
        const int row0 = u.pm * BM + wr * 64 + fr; const int colt = u.pn * BM; const float sc0 = (colt < scale_cols) ? scale0 : scale1;
        const int col0 = colt + wc * 32 + 8 * fq;
        float rinv[2][4]; if constexpr (ROWINV > 0) row_inv8<ROWINV>(ssqp, row0, fq, rinv);
#pragma unroll
        for (int ai = 0; ai < 2; ++ai)
#pragma unroll
            for (int m = 0; m < 4; ++m) { bf16_t* rowp = O + (size_t)(row0 + ai * HALF + m * 16) * ldc + col0;
                float sc = sc0; if constexpr (ROWINV > 0) sc *= rinv[ai][m];
#pragma unroll
                for (int bj = 0; bj < 2; ++bj) { const f32x4 v0 = acc[ai][bj][m][0] * sc, v1 = acc[ai][bj][m][1] * sc;
                    u32x4 w; w.x = cvt_pk_bf16(v0[0], v0[1]); w.y = cvt_pk_bf16(v0[2], v0[3]); w.z = cvt_pk_bf16(v1[0], v1[1]); w.w = cvt_pk_bf16(v1[2], v1[3]);
                    *(u32x4*)(rowp + bj * HALF) = w; } }
    }
};
struct EpiF32G {
    static constexpr bool PERM = false, AFTER_DRAIN = false;
    static constexpr int NST = 32;
    float* C; int M; float s;
    __device__ __forceinline__ void operator()(const f32x4 (&acc)[2][2][4][2], const Unit& u, int wr, int wc, int fr, int fq) const {
        const int row0 = u.pm * BM + wr * 64 + fr, col0 = u.pn * BM + wc * 32 + 4 * fq;
#pragma unroll
        for (int ai = 0; ai < 2; ++ai)
#pragma unroll
            for (int m = 0; m < 4; ++m) { const int row = row0 + ai * HALF + m * 16;
#pragma unroll
                for (int bj = 0; bj < 2; ++bj)
#pragma unroll
                    for (int n = 0; n < 2; ++n) { const int col = col0 + bj * HALF + n * 16; *(f32x4*)(C + ((size_t)(col >> 4) * M + row) * 16 + (col & 15)) = acc[ai][bj][m][n] * s; } }
    }
};
__device__ __forceinline__ unsigned pk2v(float lo, float hi) { typedef __bf16 bf2_t __attribute__((ext_vector_type(2))); typedef float f2_t __attribute__((ext_vector_type(2))); const f2_t v = {lo, hi}; return __builtin_bit_cast(unsigned, __builtin_convertvector(v, bf2_t)); }
__device__ __forceinline__ float bflo_(unsigned w) { return __builtin_bit_cast(float, w << 16); }
__device__ __forceinline__ float bfhi_(unsigned w) { return __builtin_bit_cast(float, w & 0xffff0000u); }
__device__ __forceinline__ unsigned cvt4_fp8(float a, float b, float c, float d) { int r = __builtin_amdgcn_cvt_pk_fp8_f32(a, b, 0, false); r = __builtin_amdgcn_cvt_pk_fp8_f32(c, d, r, true); return (unsigned)r; }
template <bool BASE_F32, bool SSQ = false, bool OUT8 = false>
struct EpiRes {
    static constexpr bool PERM = true, AFTER_DRAIN = false;
    static constexpr int NST = 16;
    const void* base; bf16_t* out; int ldc; float s; float* ssqp; unsigned char* out8 = nullptr;
    __device__ __forceinline__ void operator()(const f32x4 (&acc)[2][2][4][2], const Unit& u, int wr, int wc, int fr, int fq) const {
        const int row0 = u.pm * BM + wr * 64 + fr, col0 = u.pn * BM + wc * 32 + 8 * fq;
#pragma unroll
        for (int ai = 0; ai < 2; ++ai)
#pragma unroll
            for (int m = 0; m < 4; ++m) { const size_t off = (size_t)(row0 + ai * HALF + m * 16) * ldc + col0; float ss = 0.f;
#pragma unroll
                for (int bj = 0; bj < 2; ++bj) { const size_t i = off + bj * HALF; f32x4 b0, b1;
                    if constexpr (BASE_F32) { b0 = *(const f32x4*)((const float*)base + i); b1 = *(const f32x4*)((const float*)base + i + 4); }
                    else { const u32x4 r = *(const u32x4*)((const bf16_t*)base + i); b0 = (f32x4){bflo_(r.x), bfhi_(r.x), bflo_(r.y), bfhi_(r.y)}; b1 = (f32x4){bflo_(r.z), bfhi_(r.z), bflo_(r.w), bfhi_(r.w)}; }
                    const f32x4 v0 = b0 + acc[ai][bj][m][0] * s, v1 = b1 + acc[ai][bj][m][1] * s;
                    if constexpr (SSQ) ss += ((v0[0] * v0[0] + v0[1] * v0[1]) + (v0[2] * v0[2] + v0[3] * v0[3])) + ((v1[0] * v1[0] + v1[1] * v1[1]) + (v1[2] * v1[2] + v1[3] * v1[3]));
                    u32x4 w; w.x = pk2v(v0[0], v0[1]); w.y = pk2v(v0[2], v0[3]); w.z = pk2v(v1[0], v1[1]); w.w = pk2v(v1[2], v1[3]);
                    *(u32x4*)(out + i) = w;
                    if constexpr (OUT8) { typedef unsigned u32x2 __attribute__((ext_vector_type(2))); u32x2 w8;
                        w8.x = cvt4_fp8(__builtin_amdgcn_fmed3f(v0[0], -448.f, 448.f), __builtin_amdgcn_fmed3f(v0[1], -448.f, 448.f), __builtin_amdgcn_fmed3f(v0[2], -448.f, 448.f), __builtin_amdgcn_fmed3f(v0[3], -448.f, 448.f));
                        w8.y = cvt4_fp8(__builtin_amdgcn_fmed3f(v1[0], -448.f, 448.f), __builtin_amdgcn_fmed3f(v1[1], -448.f, 448.f), __builtin_amdgcn_fmed3f(v1[2], -448.f, 448.f), __builtin_amdgcn_fmed3f(v1[3], -448.f, 448.f));
                        *(u32x2*)(out8 + i) = w8; } }
                if constexpr (SSQ) { ss += __shfl_xor(ss, 16); ss += __shfl_xor(ss, 32); if (fq == 0) ssqp[(size_t)(row0 + ai * HALF + m * 16) * 16 + u.pn * 4 + wc] = ss; }
                asm volatile("" ::: "memory"); }
    }
};
__device__ __forceinline__ float sigmoidf_(float v) { return __builtin_amdgcn_rcpf(1.0f + __builtin_amdgcn_exp2f(v * -1.4426950408889634f)); }
template <int ROWINV = 0>
struct EpiSwiGLU {
    static constexpr bool PERM = true, AFTER_DRAIN = false;
    static constexpr int NST = 8;
    bf16_t* H; int ldh; const float* ssqp;
    __device__ __forceinline__ void operator()(const f32x4 (&acc)[2][2][4][2], const Unit& u, int wr, int wc, int fr, int fq) const {
        const int row0 = u.pm * BM + wr * 64 + fr, col0 = u.pn * HALF + wc * 32 + 8 * fq;
        float rinv[2][4]; if constexpr (ROWINV > 0) row_inv8<ROWINV>(ssqp, row0, fq, rinv);
#pragma unroll
        for (int ai = 0; ai < 2; ++ai)
#pragma unroll
            for (int m = 0; m < 4; ++m) { bf16_t* rowp = H + (size_t)(row0 + ai * HALF + m * 16) * ldh + col0;
                f32x4 h0, h1; float inv = 1.f, inv2 = 1.f; if constexpr (ROWINV > 0) { inv = rinv[ai][m]; inv2 = inv * inv; }
#pragma unroll
                for (int j = 0; j < 4; ++j) { const float g0 = acc[ai][0][m][0][j], g1 = acc[ai][0][m][1][j];
                    if constexpr (ROWINV > 0) { h0[j] = (g0 * acc[ai][1][m][0][j]) * (inv2 * sigmoidf_(g0 * inv)); h1[j] = (g1 * acc[ai][1][m][1][j]) * (inv2 * sigmoidf_(g1 * inv)); }
                    else { h0[j] = g0 * sigmoidf_(g0) * acc[ai][1][m][0][j]; h1[j] = g1 * sigmoidf_(g1) * acc[ai][1][m][1][j]; } }
                u32x4 w; w.x = cvt_pk_bf16(h0[0], h0[1]); w.y = cvt_pk_bf16(h0[2], h0[3]); w.z = cvt_pk_bf16(h1[0], h1[1]); w.w = cvt_pk_bf16(h1[2], h1[3]);
                *(u32x4*)rowp = w; }
    }
};
struct EpiGluRes {
    static constexpr bool PERM = true, AFTER_DRAIN = false;
    static constexpr int NST = 16;
    const bf16_t* base; bf16_t* out; int ldc; unsigned char* out8; float* ssqp; float s;
    __device__ __forceinline__ void operator()(const f32x4 (&acc)[2][2][4][2], const Unit& u, int wr, int wc, int fr, int fq) const {
        typedef unsigned u32x2 __attribute__((ext_vector_type(2)));
        const int row0 = u.pm * BM + wr * 64 + fr, col0 = u.pn * HALF + wc * 32 + 8 * fq;
#pragma unroll
        for (int ai = 0; ai < 2; ++ai)
#pragma unroll
            for (int m = 0; m < 4; ++m) { const size_t i = (size_t)(row0 + ai * HALF + m * 16) * ldc + col0;
                const u32x4 r = *(const u32x4*)(base + i);
                f32x4 v0 = (f32x4){bflo_(r.x), bfhi_(r.x), bflo_(r.y), bfhi_(r.y)}, v1 = (f32x4){bflo_(r.z), bfhi_(r.z), bflo_(r.w), bfhi_(r.w)};
#pragma unroll
                for (int j = 0; j < 4; ++j) { v0[j] += (acc[ai][0][m][0][j] * s) * sigmoidf_(acc[ai][1][m][0][j] * s); v1[j] += (acc[ai][0][m][1][j] * s) * sigmoidf_(acc[ai][1][m][1][j] * s); }
                u32x4 w; w.x = pk2v(v0[0], v0[1]); w.y = pk2v(v0[2], v0[3]); w.z = pk2v(v1[0], v1[1]); w.w = pk2v(v1[2], v1[3]);
                *(u32x4*)(out + i) = w;
                float ss = ((v0[0] * v0[0] + v0[1] * v0[1]) + (v0[2] * v0[2] + v0[3] * v0[3])) + ((v1[0] * v1[0] + v1[1] * v1[1]) + (v1[2] * v1[2] + v1[3] * v1[3]));
#pragma unroll
                for (int j = 0; j < 4; ++j) { v0[j] = __builtin_amdgcn_fmed3f(v0[j], -448.f, 448.f); v1[j] = __builtin_amdgcn_fmed3f(v1[j], -448.f, 448.f); }
                u32x2 w8; w8.x = cvt4_fp8(v0[0], v0[1], v0[2], v0[3]); w8.y = cvt4_fp8(v1[0], v1[1], v1[2], v1[3]);
                *(u32x2*)(out8 + i) = w8;
                ss += __shfl_xor(ss, 16); ss += __shfl_xor(ss, 32); if (fq == 0) ssqp[(size_t)(row0 + ai * HALF + m * 16) * 32 + u.pn * 4 + wc] = ss;
                asm volatile("" ::: "memory"); }
    }
};
struct EpiRowScaleBf16 {
    static constexpr bool PERM = true, AFTER_DRAIN = false;
    static constexpr int NST = 16;
    bf16_t* Y; int ldc; const float* roww; float s;
    __device__ __forceinline__ void operator()(const f32x4 (&acc)[2][2][4][2], const Unit& u, int wr, int wc, int fr, int fq) const {
        const int row0 = u.pm * BM + wr * 64 + fr; const int col0 = u.pn * BM + wc * 32 + 8 * fq;
#pragma unroll
        for (int ai = 0; ai < 2; ++ai)
#pragma unroll
            for (int m = 0; m < 4; ++m) { const int row = row0 + ai * HALF + m * 16; const float sc = roww[row] * s; bf16_t* rowp = Y + (size_t)row * ldc + col0;
#pragma unroll
                for (int bj = 0; bj < 2; ++bj) { const f32x4 v0 = acc[ai][bj][m][0] * sc, v1 = acc[ai][bj][m][1] * sc;
                    u32x4 w; w.x = cvt_pk_bf16(v0[0], v0[1]); w.y = cvt_pk_bf16(v0[2], v0[3]); w.z = cvt_pk_bf16(v1[0], v1[1]); w.w = cvt_pk_bf16(v1[2], v1[3]);
                    *(u32x4*)(rowp + bj * HALF) = w; } }
    }
};
template <int ROWINV = 0>
struct EpiSwiGLU8 {
    static constexpr bool PERM = true, AFTER_DRAIN = false;
    static constexpr int NST = 8;
    unsigned char* H; int ldh; float sin, sout; const float* ssqp;
    __device__ __forceinline__ void operator()(const f32x4 (&acc)[2][2][4][2], const Unit& u, int wr, int wc, int fr, int fq) const {
        const int row0 = u.pm * BM + wr * 64 + fr, col0 = u.pn * HALF + wc * 32 + 8 * fq;
        typedef unsigned u32x2 __attribute__((ext_vector_type(2)));
        const float c1_ = -1.4426950408889634f * sin, c2_ = sin * sin * sout;
        float rinv[2][4]; if constexpr (ROWINV > 0) row_inv8<ROWINV>(ssqp, row0, fq, rinv);
#pragma unroll
        for (int ai = 0; ai < 2; ++ai)
#pragma unroll
            for (int m = 0; m < 4; ++m) { unsigned char* rowp = H + (size_t)(row0 + ai * HALF + m * 16) * ldh + col0;
                f32x4 h0, h1; float c1 = c1_, c2 = c2_; if constexpr (ROWINV > 0) { const float inv = rinv[ai][m]; c1 *= inv; c2 *= inv * inv; }
#pragma unroll
                for (int j = 0; j < 4; ++j) { const float g0 = acc[ai][0][m][0][j], g1 = acc[ai][0][m][1][j];
                    const float r0 = __builtin_amdgcn_rcpf(1.0f + __builtin_amdgcn_exp2f(g0 * c1)), r1 = __builtin_amdgcn_rcpf(1.0f + __builtin_amdgcn_exp2f(g1 * c1));
                    h0[j] = __builtin_amdgcn_fmed3f((g0 * acc[ai][1][m][0][j]) * (r0 * c2), -448.f, 448.f);
                    h1[j] = __builtin_amdgcn_fmed3f((g1 * acc[ai][1][m][1][j]) * (r1 * c2), -448.f, 448.f); }
                u32x2 w; w.x = cvt4_fp8(h0[0], h0[1], h0[2], h0[3]); w.y = cvt4_fp8(h1[0], h1[1], h1[2], h1[3]);
                *(u32x2*)rowp = w; asm volatile("" ::: "memory"); }
    }
};
typedef int v8i_t __attribute__((ext_vector_type(8)));
typedef int v4i_t __attribute__((ext_vector_type(4)));
template <int N> __device__ __forceinline__ void pg8_wait_v() { asm volatile("s_waitcnt vmcnt(%0)" :: "n"(N) : "memory"); }
template <class Epi, class Sched, bool ALIGN_EPI = false, bool SP2 = false, bool FP8 = false>
__device__ __forceinline__ void gemm_phase(PG8_LAS unsigned char* lds, const Gemm g, const Sched& S, const Epi& E) {
    const int lane = lane_asm(), wid = g.wave, tid = wid * 64 + lane, wr = wid >> 2, wc = wid & 3, fr = lane & 15, fq = lane >> 4;
    const int K = g.K, nt = K / BK;
    unsigned voffA[2], voffB[2];
#pragma unroll
    for (int i = 0; i < 2; ++i) { int R, C; stage_rc(tid * 16 + i * 8192, R, C); const int Rb = Epi::PERM ? ((R & ~31) + perm32(R & 31)) : R;
        voffB[i] = (unsigned)(Rb * K + C) * 2u; }
    const unsigned rsA_ = g.a_rs ? g.a_rs : (unsigned)K * 2u, psA_ = g.a_ps ? g.a_ps : 16u;
#pragma unroll
    for (int i = 0; i < 2; ++i) { int R, C; stage_rc(tid * 16 + i * 8192, R, C); voffA[i] = (unsigned)R * rsA_ + (unsigned)(C >> 3) * psA_; }
    const unsigned kstep = (unsigned)(BK * 2);
    const unsigned hstep = (unsigned)HALF * K * 2;
    const unsigned tstep = 2 * hstep; const unsigned bstr = (unsigned)g.bstride;
    const unsigned kstepA = 8u * psA_, hstepA = (unsigned)HALF * rsA_, tstepA = 2u * hstepA;
    const __amdgpu_buffer_rsrc_t rsA = __builtin_amdgcn_make_buffer_rsrc((void*)g.A, 0, 0x7fffffff, 0x00020000), rsB = __builtin_amdgcn_make_buffer_rsrc((void*)g.Bt, 0, 0x7fffffff, 0x00020000);
    const unsigned ldsw = (unsigned)wid * 1024u;
    const int aoff = lds_byte(wr * 64 + fr, fq * 8), boff = lds_byte(wc * 32 + fr, fq * 8);
#define PG8_SA(b, h) (((b) * 2 + (h)) * HTB)
#define PG8_SB(b, h) ((4 + (b) * 2 + (h)) * HTB)
#define PG8_STAGE_(rs, bufoff, goff, voff) do { _Pragma("unroll") for (int _i = 0; _i < 2; ++_i) \
        __builtin_amdgcn_raw_ptr_buffer_load_lds(rs, (PG8_LAS void*)(lds + (bufoff) + ldsw + _i * 8192), 16, (int)(voff)[_i], (int)(goff), 0, 0); } while (0)
#define PG8_STAGEA(bufoff, goff, voff) PG8_STAGE_(rsA, bufoff, goff, voff)
#define PG8_STAGEB(bufoff, goff, voff) PG8_STAGE_(rsB, bufoff, goff, voff)
#define PG8_LD8(p) __builtin_shufflevector(*(const PG8_LAS v4i_t*)(p), *(const PG8_LAS v4i_t*)((p) + 1024), 0, 1, 2, 3, 4, 5, 6, 7)
#define PG8_LDA(dst, b, h) do { if constexpr (FP8) { _Pragma("unroll") for (int m = 0; m < 4; ++m) dst##8[m] = PG8_LD8(lds + PG8_SA(b, h) + aoff + m * 2048); } else { \
        _Pragma("unroll") for (int m = 0; m < 4; ++m) _Pragma("unroll") for (int k = 0; k < 2; ++k) dst[m][k] = *(const PG8_LAS bf16x8*)(lds + PG8_SA(b, h) + aoff + m * 2048 + k * 1024); } } while (0)
#define PG8_LDB(dst, b, h) do { if constexpr (FP8) { _Pragma("unroll") for (int n = 0; n < 2; ++n) dst##8[n] = PG8_LD8(lds + PG8_SB(b, h) + boff + n * 2048); } else { \
        _Pragma("unroll") for (int n = 0; n < 2; ++n) _Pragma("unroll") for (int k = 0; k < 2; ++k) dst[n][k] = *(const PG8_LAS bf16x8*)(lds + PG8_SB(b, h) + boff + n * 2048 + k * 1024); } } while (0)
#define PG8_CAT(x) __builtin_shufflevector(__builtin_bit_cast(v4i_t, (x)[0]), __builtin_bit_cast(v4i_t, (x)[1]), 0, 1, 2, 3, 4, 5, 6, 7)
#define PG8_MMA(ai, bj, At, Bt) do { __builtin_amdgcn_s_setprio(1); if constexpr (FP8) { _Pragma("unroll") for (int m = 0; m < 4; ++m) _Pragma("unroll") for (int n = 0; n < 2; ++n) \
        acc[ai][bj][m][n] = __builtin_amdgcn_mfma_scale_f32_16x16x128_f8f6f4(Bt##8[n], At##8[m], acc[ai][bj][m][n], 0, 0, 0, sc8, 0, sc8); } \
      else { _Pragma("unroll") for (int m = 0; m < 4; ++m) _Pragma("unroll") for (int n = 0; n < 2; ++n) _Pragma("unroll") for (int k = 0; k < 2; ++k) \
        acc[ai][bj][m][n] = __builtin_amdgcn_mfma_f32_16x16x32_bf16(Bt[n][k], At[m][k], acc[ai][bj][m][n], 0, 0, 0); } __builtin_amdgcn_s_setprio(0); } while (0)
#define PG8_WAIT_V(n) asm volatile("s_waitcnt vmcnt(" #n ")" ::: "memory")
#define PG8_WAIT_L(n) asm volatile("s_waitcnt lgkmcnt(" #n ")" ::: "memory")
#define PG8_BAR __builtin_amdgcn_s_barrier()
#define PG8_SCHED __builtin_amdgcn_sched_barrier(0)
#define PG8_KITER_SP2(WV) do { \
            PG8_LDB(B0, 0, 0); PG8_LDB(B1, 0, 1); PG8_SCHED; PG8_LDA(At, 0, 0); PG8_STAGEA(PG8_SA(1, 1), a1 + hstepA, voffA); \
            pg8_wait_v<WV>(); PG8_WAIT_L(0); PG8_BAR; PG8_MMA(0, 0, At, B0); PG8_MMA(0, 1, At, B1); PG8_BAR; PG8_SCHED; \
            PG8_LDA(At, 0, 1); PG8_STAGEB(PG8_SB(0, 0), b2, voffB); PG8_STAGEB(PG8_SB(0, 1), b2 + hstep, voffB); PG8_STAGEA(PG8_SA(0, 0), a2, voffA); \
            pg8_wait_v<WV>(); PG8_WAIT_L(0); PG8_BAR; PG8_MMA(1, 0, At, B0); PG8_MMA(1, 1, At, B1); PG8_BAR; PG8_SCHED; \
            PG8_LDB(B0, 1, 0); PG8_LDB(B1, 1, 1); PG8_SCHED; PG8_LDA(At, 1, 0); PG8_STAGEA(PG8_SA(0, 1), a2 + hstepA, voffA); \
            PG8_WAIT_V(8); PG8_WAIT_L(0); PG8_BAR; PG8_MMA(0, 0, At, B0); PG8_MMA(0, 1, At, B1); PG8_BAR; PG8_SCHED; \
            PG8_LDA(At, 1, 1); PG8_STAGEB(PG8_SB(1, 0), b3, voffB); PG8_STAGEB(PG8_SB(1, 1), b3 + hstep, voffB); PG8_STAGEA(PG8_SA(1, 0), a3, voffA); \
            PG8_WAIT_V(8); PG8_WAIT_L(0); PG8_BAR; PG8_MMA(1, 0, At, B0); PG8_MMA(1, 1, At, B1); PG8_BAR; PG8_SCHED; \
        } while (0)
    Unit cur, nxt; int ui = 0;
    if (!S.next(0, cur)) return;
    f32x4 acc[2][2][4][2];
#pragma unroll
    for (int a = 0; a < 2; ++a)
#pragma unroll
        for (int b = 0; b < 2; ++b)
#pragma unroll
            for (int m = 0; m < 4; ++m)
#pragma unroll
                for (int n = 0; n < 2; ++n) acc[a][b][m][n] = (f32x4){0.f, 0.f, 0.f, 0.f};
    bf16x8 At[4][2], B0[2][2], B1[2][2]; v8i_t At8[4], B08[2], B18[2]; const int sc8 = __builtin_amdgcn_readfirstlane(0x7F7F7F7F);
    unsigned cA = (unsigned)cur.pm * tstepA, cB = (unsigned)cur.e * bstr + (unsigned)cur.pn * tstep;
    S.a_ready(cur);
    if constexpr (SP2) {
        PG8_STAGEB(PG8_SB(0, 0), cB, voffB); PG8_STAGEB(PG8_SB(0, 1), cB + hstep, voffB); PG8_STAGEA(PG8_SA(0, 0), cA, voffA); PG8_STAGEA(PG8_SA(0, 1), cA + hstepA, voffA);
        if (wr == 1) PG8_BAR;
        PG8_WAIT_V(2); PG8_BAR;
        PG8_STAGEB(PG8_SB(1, 0), cB + kstep, voffB); PG8_STAGEA(PG8_SA(1, 0), cA + kstepA, voffA); PG8_STAGEB(PG8_SB(1, 1), cB + hstep + kstep, voffB);
        PG8_WAIT_V(6); PG8_BAR;
#pragma unroll
        for (int i = 0; i < Epi::NST; ++i) __builtin_amdgcn_raw_ptr_buffer_load_lds(rsA, (PG8_LAS void*)(lds + STAGE_BYTES + 2048 + wid * 512), 4, 4 * i, 0, 0, 0);
    } else {
        PG8_STAGEB(PG8_SB(0, 0), cB, voffB); PG8_STAGEA(PG8_SA(0, 0), cA, voffA); PG8_STAGEB(PG8_SB(0, 1), cB + hstep, voffB); PG8_STAGEA(PG8_SA(0, 1), cA + hstepA, voffA);
        if (wr == 1) PG8_BAR;
        PG8_WAIT_V(4); PG8_BAR;
        PG8_STAGEB(PG8_SB(1, 0), cB + kstep, voffB); PG8_STAGEA(PG8_SA(1, 0), cA + kstepA, voffA); PG8_STAGEB(PG8_SB(1, 1), cB + hstep + kstep, voffB);
        PG8_WAIT_V(6); PG8_BAR;
    }
    for (;;) {
        const bool has_next = S.next(ui + 1, nxt);
        const unsigned nA = has_next ? (unsigned)nxt.pm * tstepA : cA, nB = has_next ? (unsigned)nxt.e * bstr + (unsigned)nxt.pn * tstep : cB;
        if constexpr (SP2) {
            int t = 0;
            { const bool last = false; const unsigned a1 = cA + kstepA, a2 = cA + 2u * kstepA, b2 = cB + 2u * kstep, a3 = a2 + kstepA, b3 = b2 + kstep; (void)last;
              PG8_KITER_SP2(8 + Epi::NST); }
#pragma unroll 1
            for (t = 2; t < nt; t += 2) {
                const bool last = (t == nt - 2);
                const unsigned a1 = cA + (unsigned)(t + 1) * kstepA;
                const unsigned a2 = last ? nA : cA + (unsigned)(t + 2) * kstepA, b2 = last ? nB : cB + (unsigned)(t + 2) * kstep;
                const unsigned a3 = a2 + kstepA, b3 = b2 + kstep;
                if (last && has_next) S.a_ready(nxt);
                PG8_KITER_SP2(8);
            }
        } else {
#pragma unroll 1
        for (int t = 0; t < nt; t += 2) {
            const bool last = (t == nt - 2);
            const unsigned a1 = cA + (unsigned)(t + 1) * kstepA;
            const unsigned a2 = last ? nA : cA + (unsigned)(t + 2) * kstepA, b2 = last ? nB : cB + (unsigned)(t + 2) * kstep;
            const unsigned a3 = a2 + kstepA, b3 = b2 + kstep;
            if (last && has_next) S.a_ready(nxt);
            {
            PG8_LDB(B0, 0, 0); PG8_SCHED; PG8_LDA(At, 0, 0); PG8_STAGEA(PG8_SA(1, 1), a1 + hstepA, voffA);
            PG8_WAIT_L(8); PG8_BAR; PG8_WAIT_L(0); PG8_MMA(0, 0, At, B0); PG8_BAR; PG8_SCHED;
            PG8_LDB(B1, 0, 1); PG8_STAGEB(PG8_SB(0, 0), b2, voffB);
            PG8_BAR; PG8_WAIT_L(0); PG8_MMA(0, 1, At, B1); PG8_BAR;
            PG8_LDA(At, 0, 1); PG8_STAGEA(PG8_SA(0, 0), a2, voffA);
            PG8_BAR; PG8_WAIT_L(0); PG8_MMA(1, 0, At, B0); PG8_BAR; PG8_SCHED;
            PG8_STAGEB(PG8_SB(0, 1), b2 + hstep, voffB);
            PG8_WAIT_V(6); PG8_BAR; PG8_MMA(1, 1, At, B1); PG8_BAR;
            PG8_LDB(B0, 1, 0); PG8_SCHED; PG8_LDA(At, 1, 0); PG8_STAGEA(PG8_SA(0, 1), a2 + hstepA, voffA);
            PG8_WAIT_L(8); PG8_BAR; PG8_WAIT_L(0); PG8_MMA(0, 0, At, B0); PG8_BAR; PG8_SCHED;
            PG8_LDB(B1, 1, 1); PG8_STAGEB(PG8_SB(1, 0), b3, voffB);
            PG8_BAR; PG8_WAIT_L(0); PG8_MMA(0, 1, At, B1); PG8_BAR;
            PG8_LDA(At, 1, 1); PG8_STAGEA(PG8_SA(1, 0), a3, voffA);
            PG8_BAR; PG8_WAIT_L(0); PG8_MMA(1, 0, At, B0); PG8_BAR; PG8_SCHED;
            PG8_STAGEB(PG8_SB(1, 1), b3 + hstep, voffB);
            PG8_WAIT_V(6); PG8_BAR; PG8_MMA(1, 1, At, B1); PG8_BAR;
            }
        }
        }
        if constexpr (ALIGN_EPI) { if (wr == 0) PG8_BAR; }
        if constexpr (!Epi::AFTER_DRAIN) { const int l2 = lane_asm();
            E(acc, cur, wr, wc, l2 & 15, l2 >> 4); S.done(cur); }
        if (!has_next) break;
#pragma unroll
        for (int a = 0; a < 2; ++a)
#pragma unroll
            for (int b = 0; b < 2; ++b)
#pragma unroll
                for (int m = 0; m < 4; ++m)
#pragma unroll
                    for (int n = 0; n < 2; ++n) acc[a][b][m][n] = (f32x4){0.f, 0.f, 0.f, 0.f};
        cur = nxt; cA = nA; cB = nB; ++ui;
        if constexpr (ALIGN_EPI) { if (wr == 1) PG8_BAR; }
    }
    PG8_WAIT_V(0);
    if constexpr (!ALIGN_EPI) { if (wr == 0) PG8_BAR; }
    PG8_BAR;
    if constexpr (Epi::AFTER_DRAIN) { E.fused(acc, cur, wr, wc, fr, fq, lds, wid, lane); S.done(cur); }
#undef PG8_SA
#undef PG8_SB
#undef PG8_STAGE_
#undef PG8_STAGEA
#undef PG8_STAGEB
#undef PG8_LDA
#undef PG8_LDB
#undef PG8_MMA
#undef PG8_CAT
#undef PG8_LD8
#undef PG8_WAIT_V
#undef PG8_WAIT_L
#undef PG8_BAR
#undef PG8_SCHED
#undef PG8_KITER_SP2
}
}

#ifndef MK_PER_PHASE
#define MK_PER_PHASE 0
#endif
#ifndef LDSMM_SCALAR
#define LDSMM_SCALAR 0
#endif

#ifndef PROBE
#define PROBE 0
#endif
#ifndef AT_FP8
#define AT_FP8 1
#endif
#ifndef S5_FP8
#define S5_FP8 1
#endif
constexpr int NWAVES = 8, NTHR = 512;
constexpr int T = 16384, D = 1024, SEQ = 4096, NB = 4;
constexpr int FFD = 2816, FFE = 3584, NEXP = 8;
constexpr int MAXSLOT = 34816, MAXPANEL = 136;
constexpr float EPS = 1e-6f;

constexpr size_t MiB = 1u << 20;
constexpr size_t WS_CTL = 0, CTL_ZERO_BYTES = 32768;
constexpr size_t WS_TAB = 1 * MiB;
constexpr size_t TAB_GATES = WS_TAB;
constexpr size_t TAB_BC = WS_TAB + 1 * MiB;
constexpr size_t TAB_PC = TAB_BC + 8192, TAB_MPREV = TAB_PC + 8192;
constexpr size_t TAB_NU = WS_TAB + 2 * MiB;
constexpr size_t TAB_NS = WS_TAB + 3 * MiB;
constexpr size_t TAB_MOE = WS_TAB + 4 * MiB;
constexpr size_t MOE_TE = 0, MOE_TW = 65536, MOE_SLOT = 196608, MOE_GW = 327680, MOE_CNT = 524288, MOE_PANEL = 532480;
constexpr size_t WS_W = 8 * MiB;
constexpr size_t W_ML_IN = WS_W, W_ML_OUT = WS_W + 12 * MiB, W_AT_IN = WS_W + 16 * MiB, W_AT_OUT = WS_W + 22 * MiB, W_S5_IN = WS_W + 24 * MiB, W_S5_OUT = WS_W + 26 * MiB;
constexpr size_t W_FF_GU = WS_W + 30 * MiB, W_FF_D = WS_W + 52 * MiB, W_MOE_GU = WS_W + 63 * MiB, W_MOE_D = WS_W + 175 * MiB;
constexpr size_t SZ_ML_IN = 6 * MiB, SZ_ML_OUT = 2 * MiB, SZ_FF_GU = 11 * MiB, SZ_FF_D = (size_t)D * FFD * 2, SZ_MOE_GU = 7 * MiB, SZ_MOE_D = 7 * MiB / 2;
constexpr size_t WS_X = 407 * MiB, WS_X8 = 439 * MiB, WS_SSQ = 455 * MiB, WS_XN = 471 * MiB, WS_R = 503 * MiB;
constexpr size_t WS_PROJ = WS_R, WS_U32 = WS_R, WS_H = WS_R, WS_QKC = WS_R + 96 * MiB, WS_UC = WS_R + 128 * MiB, WS_CS = WS_R + 192 * MiB, WS_G = WS_R + 256 * MiB;
constexpr size_t WS_XG = WS_R + 238 * MiB, WS_Y = WS_XG, WS_END = WS_R + 306 * MiB;
static_assert(W_FF_D + 2 * SZ_FF_D <= W_MOE_GU && W_MOE_GU + 16 * SZ_MOE_GU == W_MOE_D && W_MOE_D + 16 * SZ_MOE_D <= WS_X, "weight map");
static_assert((size_t)MAXSLOT * FFE * 2 <= 238 * MiB && (size_t)MAXSLOT * D * 2 <= 68 * MiB, "MoE buffers");

constexpr int CW_TMO = 0;
constexpr int CW_BAR = 4096;

constexpr int RING_BYTES = 131072;
constexpr int MISC_OFF = RING_BYTES + 320;
constexpr int LDS_BYTES = 147456;

#define GAS __attribute__((address_space(1)))
#define LAS __attribute__((address_space(3)))
typedef unsigned short bf16;
typedef unsigned v4u __attribute__((ext_vector_type(4)));
typedef unsigned v2u __attribute__((ext_vector_type(2)));
typedef float f32x4 __attribute__((ext_vector_type(4)));
typedef short bf16x8 __attribute__((ext_vector_type(8)));
using pg8::sigmoidf_;
#define LDS_WAIT() asm volatile("s_waitcnt lgkmcnt(0)" ::: "memory")
__device__ __forceinline__ unsigned f2bf(float f) { unsigned u = __builtin_bit_cast(unsigned, f); return (u + 0x7fffu + ((u >> 16) & 1u)) >> 16; }
typedef __bf16 bf16x2_t __attribute__((ext_vector_type(2)));
typedef float f32x2_t __attribute__((ext_vector_type(2)));
__device__ __forceinline__ unsigned pk2(float lo, float hi) { const f32x2_t v = {lo, hi}; return __builtin_bit_cast(unsigned, __builtin_convertvector(v, bf16x2_t)); }
__device__ __forceinline__ float bf2f(unsigned v) { return __builtin_bit_cast(float, v << 16); }
__device__ __forceinline__ float bflo(unsigned w) { return __builtin_bit_cast(float, w << 16); }
__device__ __forceinline__ float bfhi(unsigned w) { return __builtin_bit_cast(float, w & 0xffff0000u); }
__device__ __forceinline__ float wave_sum(float v) {
#pragma unroll
    for (int o = 1; o < 64; o <<= 1) v += __shfl_xor(v, o);
    return v;
}
__device__ __forceinline__ float wave_max(float v) {
#pragma unroll
    for (int o = 1; o < 64; o <<= 1) v = fmaxf(v, __shfl_xor(v, o));
    return v;
}

#define XB_TMO      128
#define XB_XCNT(j)  (256  + 64 * (j))
#define XB_XSUB(j)  (1280 + 64 * (j))
#define XB_XGEN(j)  (2304 + 64 * (j))
#define XB_TOP      3328
#define XB_TOPGEN   3392
#define XCD_BAR_WORDS 3456
#define XB_SPIN_CAP (1u << 18)

__device__ __forceinline__ unsigned xb_ld(unsigned* p)              { return __hip_atomic_load(p, __ATOMIC_RELAXED, __HIP_MEMORY_SCOPE_AGENT); }
__device__ __forceinline__ unsigned xb_add(unsigned* p, unsigned v) { return __hip_atomic_fetch_add(p, v, __ATOMIC_RELAXED, __HIP_MEMORY_SCOPE_AGENT); }
__device__ __forceinline__ unsigned xb_xcc_id() { return (unsigned)__builtin_amdgcn_s_getreg((3 << 11) | 20) & 0xFu; }
#define XB_SPIN(cond, bar) do { unsigned _sp = 0; while (cond) { __builtin_amdgcn_s_sleep(1); \
    if ((++_sp & 255u) == 0u) { if (xb_ld(&(bar)[XB_TMO])) break; if (_sp > XB_SPIN_CAP) { atomicAdd(&(bar)[XB_TMO], 1u); break; } } } } while (0)

struct XcdBarrier {
    unsigned* bar; unsigned x; int wave;
    volatile LAS unsigned* st;
};

__device__ __forceinline__ XcdBarrier xcd_barrier_post(unsigned* bar, volatile LAS unsigned* st, int wave) {
    XcdBarrier b; b.bar = bar; b.x = xb_xcc_id(); b.st = st; b.wave = wave;
    if (wave == 0 && pg8::lane_asm() == 0) (void)xb_add(&bar[XB_XCNT(b.x)], 1u);
    return b;
}
__device__ __forceinline__ void xcd_barrier_complete(unsigned* bar, unsigned x, unsigned& nloc, unsigned& nx) {
    const unsigned G = gridDim.x * gridDim.y * gridDim.z;
    unsigned sum, cnt, mine, sp = 0u;
    for (;;) {
        sum = 0u; cnt = 0u; mine = 0u;
#pragma unroll
        for (unsigned j = 0; j < 16; ++j) { const unsigned c = xb_ld(&bar[XB_XCNT(j)]); sum += c; cnt += (c > 0u) ? 1u : 0u; mine = (j == x) ? c : mine; }
        if (sum == G) break;
        __builtin_amdgcn_s_sleep(1);
        if ((++sp & 255u) == 0u) { if (xb_ld(&bar[XB_TMO])) break; if (sp > XB_SPIN_CAP) { atomicAdd(&bar[XB_TMO], 1u); break; } }
    }
    nloc = mine > 0u ? mine : 1u; nx = cnt > 0u ? cnt : 1u;
}

__device__ __forceinline__ void xcd_barrier(const XcdBarrier& b) {
    asm volatile("s_waitcnt vmcnt(0)" ::: "memory");
    __syncthreads();
    if (b.wave == 0 && pg8::lane_asm() == 0) {
        unsigned* bar = b.bar;
        __builtin_amdgcn_s_waitcnt(0);
        unsigned nloc = b.st[0], nx = b.st[1];
        if (nloc == 0u) { xcd_barrier_complete(bar, b.x, nloc, nx); b.st[0] = nloc; b.st[1] = nx; }
        const unsigned old = xb_add(&bar[XB_XSUB(b.x)], 1u);
        const unsigned gen = old / nloc;
        if (old + 1u == (gen + 1u) * nloc) {
            __builtin_amdgcn_fence(__ATOMIC_RELEASE, "agent");
            asm volatile("s_waitcnt vmcnt(0)" ::: "memory");
            const unsigned og = xb_add(&bar[XB_TOP], 1u);
            const unsigned tg = og / nx;
            if (og + 1u == (tg + 1u) * nx) xb_add(&bar[XB_TOPGEN], 1u);
            else XB_SPIN(xb_ld(&bar[XB_TOPGEN]) == tg, bar);
            __builtin_amdgcn_fence(__ATOMIC_ACQUIRE, "agent");
            xb_add(&bar[XB_XGEN(b.x)], 1u);
            asm volatile("s_waitcnt vmcnt(0)" ::: "memory");
        } else {
            XB_SPIN(xb_ld(&bar[XB_XGEN(b.x)]) == gen, bar);
            __builtin_amdgcn_fence(__ATOMIC_ACQUIRE, "agent");
            asm volatile("s_waitcnt vmcnt(0)" ::: "memory");
        }
    }
    __syncthreads();
}

typedef short s16x4 __attribute__((ext_vector_type(4)));
__device__ __forceinline__ s16x4 lds_tr16(const LAS bf16* p) { return __builtin_bit_cast(s16x4, __builtin_amdgcn_ds_read_tr16_b64_v4i16((LAS s16x4*)p)); }
template <bool TR>
__device__ __forceinline__ bf16x8 ldfrag(const LAS bf16* base, int ld, int x0, int k0, int lane) {
    if constexpr (!TR) { return *(const LAS bf16x8*)(base + (x0 + (lane & 15)) * ld + k0 + 8 * (lane >> 4)); }
    else { const int i = lane & 15, g = lane >> 4; const LAS bf16* p = base + (k0 + 8 * g + (i >> 2)) * ld + x0 + 4 * (i & 3);
        const s16x4 a = lds_tr16(p), b = lds_tr16(p + 4 * ld); return (bf16x8){a[0], a[1], a[2], a[3], b[0], b[1], b[2], b[3]}; }
}
template <int M, int N, int K1, bool TRA1, bool TRB1, int K2, int TN, class F>
__device__ __forceinline__ void lds_mmx(const LAS bf16* A1, int lda1, const LAS bf16* B1, int ldb1,
                                        const LAS bf16* A2, int lda2, const LAS bf16* B2, int ldb2, int wave, int lane, const F& f) {
    constexpr int MT = M / 16, NG = N / (16 * TN);
    static_assert(M % 16 == 0 && N % (16 * TN) == 0 && K1 % 32 == 0 && K2 % 32 == 0, "lds_mmx shape");
    for (int grp = wave; grp < MT * NG; grp += NWAVES) {
        const int mt = grp / NG, ng = grp - mt * NG;
        f32x4 acc[TN];
#pragma unroll
        for (int t = 0; t < TN; ++t) acc[t] = (f32x4){0.f, 0.f, 0.f, 0.f};
#pragma unroll
        for (int k = 0; k < K1; k += 32) { const bf16x8 a = ldfrag<TRA1>(A1, lda1, mt * 16, k, lane);
#pragma unroll
            for (int t = 0; t < TN; ++t) acc[t] = __builtin_amdgcn_mfma_f32_16x16x32_bf16(a, ldfrag<TRB1>(B1, ldb1, (ng * TN + t) * 16, k, lane), acc[t], 0, 0, 0); }
        if constexpr (K2 > 0) {
#pragma unroll
            for (int k = 0; k < K2; k += 32) { const bf16x8 a = ldfrag<false>(A2, lda2, mt * 16, k, lane);
#pragma unroll
                for (int t = 0; t < TN; ++t) acc[t] = __builtin_amdgcn_mfma_f32_16x16x32_bf16(a, ldfrag<false>(B2, ldb2, (ng * TN + t) * 16, k, lane), acc[t], 0, 0, 0); } }
#pragma unroll
        for (int t = 0; t < TN; ++t) f(mt * 16 + 4 * (lane >> 4), (ng * TN + t) * 16 + (lane & 15), acc[t]);
    }
}
template <int M, int N, int K1, bool TRA1, int K2, int TN, class F>
__device__ __forceinline__ void lds_mmx2(const LAS bf16* A1, int lda1, const LAS bf16* B1, int ldb1,
                                         const LAS bf16* A2, int lda2, const LAS bf16* B2, int ldb2, int wave, int lane, const F& f) {
    constexpr int MT = M / 16, NG = N / (16 * TN);
    for (int grp = wave; grp < MT * NG; grp += NWAVES) {
        const int mt = grp / NG, ng = grp - mt * NG;
        f32x4 acc1[TN], acc2[TN];
#pragma unroll
        for (int t = 0; t < TN; ++t) { acc1[t] = (f32x4){0.f, 0.f, 0.f, 0.f}; acc2[t] = (f32x4){0.f, 0.f, 0.f, 0.f}; }
#pragma unroll
        for (int k = 0; k < K1; k += 32) { const bf16x8 a = ldfrag<TRA1>(A1, lda1, mt * 16, k, lane);
#pragma unroll
            for (int t = 0; t < TN; ++t) acc1[t] = __builtin_amdgcn_mfma_f32_16x16x32_bf16(a, ldfrag<false>(B1, ldb1, (ng * TN + t) * 16, k, lane), acc1[t], 0, 0, 0); }
#pragma unroll
        for (int k = 0; k < K2; k += 32) { const bf16x8 a = ldfrag<false>(A2, lda2, mt * 16, k, lane);
#pragma unroll
            for (int t = 0; t < TN; ++t) acc2[t] = __builtin_amdgcn_mfma_f32_16x16x32_bf16(a, ldfrag<false>(B2, ldb2, (ng * TN + t) * 16, k, lane), acc2[t], 0, 0, 0); }
#pragma unroll
        for (int t = 0; t < TN; ++t) f(mt * 16 + 4 * (lane >> 4), (ng * TN + t) * 16 + (lane & 15), acc1[t], acc2[t]);
    }
}
__device__ __forceinline__ v2u pack4(f32x4 v) { v2u w; w.x = pk2(v.x, v.y); w.y = pk2(v.z, v.w); return w; }

struct Ctx { LAS unsigned char* lds; int tid, lane, wave, blk, G; };

struct Job { const float* src; bf16* dst; const float* gain; int K, N, ldw, mode, item0, pad; };
constexpr int NJOBS = 64;
__device__ __forceinline__ void tr_item(const GAS float* W, int K, int ldw, int nblk, GAS bf16* WT, int mode, LAS bf16* scr, int item, int lane, const float* gain) {
    const int kb = item / nblk, nb = item - kb * nblk, k0 = 64 * kb, n0 = 64 * nb;
    const int lr = lane >> 4, lc = (lane & 15) * 4;
    f32x4 v[16];
    const GAS float* src = W + (size_t)(k0 + 2 * lr) * ldw + n0 + lc;
#pragma unroll
    for (int i = 0; i < 8; ++i) { v[2 * i] = *(const GAS f32x4*)(src + (size_t)(8 * i) * ldw); v[2 * i + 1] = *(const GAS f32x4*)(src + (size_t)(8 * i + 1) * ldw); }
    if (gain) {
#pragma unroll
        for (int i = 0; i < 8; ++i) { v[2 * i] *= gain[k0 + 2 * lr + 8 * i]; v[2 * i + 1] *= gain[k0 + 2 * lr + 8 * i + 1]; } }
#pragma unroll
    for (int i = 0; i < 8; ++i) { LAS unsigned* d = (LAS unsigned*)(scr + lc * 72 + 8 * i + 2 * lr);
        d[0] = pk2(v[2 * i].x, v[2 * i + 1].x); d[36] = pk2(v[2 * i].y, v[2 * i + 1].y); d[72] = pk2(v[2 * i].z, v[2 * i + 1].z); d[108] = pk2(v[2 * i].w, v[2 * i + 1].w); }
    LDS_WAIT(); asm volatile("" ::: "memory");
    const int drow0 = (mode == 0) ? n0 : (256 * (n0 >> 7) + (n0 & 127) + (mode == 2 ? 128 : 0));
    const int c = lane & 7;
#pragma unroll
    for (int j = 0; j < 8; ++j) { const int n = (lane >> 3) + 8 * j; const v4u o = *(const LAS v4u*)(scr + n * 72 + 8 * c);
        *(GAS v4u*)(WT + (size_t)(drow0 + n) * K + k0 + 8 * c) = o; }
    LDS_WAIT(); asm volatile("" ::: "memory");
}
__device__ __forceinline__ void tr_item8(const GAS float* W, int K, int ldw, int nblk, GAS unsigned char* WT, int mode, float scale, LAS unsigned char* scr, int item, int lane, const float* gain) {
    const int kb = item / nblk, nb = item - kb * nblk, k0 = 128 * kb, n0 = 64 * nb;
    const int lr = lane >> 4, lc = (lane & 15) * 4;
#pragma unroll
    for (int hh = 0; hh < 2; ++hh) {
        f32x4 v[16];
        const GAS float* src = W + (size_t)(k0 + 64 * hh + 4 * lr) * ldw + n0 + lc;
#pragma unroll
        for (int i = 0; i < 4; ++i)
#pragma unroll
            for (int r = 0; r < 4; ++r) v[4 * i + r] = *(const GAS f32x4*)(src + (size_t)(16 * i + r) * ldw);
        if (gain) {
#pragma unroll
            for (int i = 0; i < 4; ++i)
#pragma unroll
                for (int r = 0; r < 4; ++r) v[4 * i + r] *= gain[k0 + 64 * hh + 4 * lr + 16 * i + r]; }
#pragma unroll
        for (int i = 0; i < 4; ++i) { LAS unsigned* d = (LAS unsigned*)(scr + lc * 144 + 64 * hh + 16 * i + 4 * lr);
            d[0] = pg8::cvt4_fp8(v[4 * i].x * scale, v[4 * i + 1].x * scale, v[4 * i + 2].x * scale, v[4 * i + 3].x * scale);
            d[36] = pg8::cvt4_fp8(v[4 * i].y * scale, v[4 * i + 1].y * scale, v[4 * i + 2].y * scale, v[4 * i + 3].y * scale);
            d[72] = pg8::cvt4_fp8(v[4 * i].z * scale, v[4 * i + 1].z * scale, v[4 * i + 2].z * scale, v[4 * i + 3].z * scale);
            d[108] = pg8::cvt4_fp8(v[4 * i].w * scale, v[4 * i + 1].w * scale, v[4 * i + 2].w * scale, v[4 * i + 3].w * scale); }
    }
    LDS_WAIT(); asm volatile("" ::: "memory");
    const int drow0 = (mode == 0) ? n0 : (256 * (n0 >> 7) + (n0 & 127) + (mode == 2 ? 128 : 0));
    const int c = lane & 7;
#pragma unroll
    for (int j = 0; j < 8; ++j) { const int n = (lane >> 3) + 8 * j; const v4u o = *(const LAS v4u*)(scr + n * 144 + 16 * c);
        *(GAS v4u*)(WT + (size_t)(drow0 + n) * K + k0 + 16 * c) = o; }
    LDS_WAIT(); asm volatile("" ::: "memory");
}
constexpr int CV_ABS1 = 3072, CV_ABS2 = 3584, CV_ABS3 = 2048;
__device__ __forceinline__ void convert_phase(const Ctx& C, const float* const* in, unsigned char* ws, int part, int worker, int nworkers) {
    LAS Job* jobs = (LAS Job*)(C.lds + 0);
    LAS int* njobs_p = (LAS int*)(C.lds + 4096);
    LAS bf16* scr = (LAS bf16*)(C.lds + 8192 + C.wave * 9216);
    if (C.tid == 0) {
        int nj = 0, it = 0;
        auto add = [&](const float* src, bf16* dst, int K, int N, int ldw, int mode, const float* gain = nullptr) {
            jobs[nj].src = src; jobs[nj].dst = dst; jobs[nj].gain = gain; jobs[nj].K = K; jobs[nj].N = N; jobs[nj].ldw = ldw; jobs[nj].mode = mode; jobs[nj].item0 = it; jobs[nj].pad = 0;
            it += (mode & 4) ? (K / 128) * (N / 64) : (K / 64) * (N / 64); ++nj; };
        for (int j = 0; j < 2; ++j) {
            add(in[4] + (size_t)j * D * 3080, (bf16*)(ws + W_ML_IN + j * SZ_ML_IN), D, 3072, 3080, j ? 4 : 0);
            add(in[8] + (size_t)j * D * D, (bf16*)(ws + W_ML_OUT + j * SZ_ML_OUT), D, D, D, j ? 4 : 0);
        }
        add(in[9], (bf16*)(ws + W_AT_IN), D, 3072, 3072, AT_FP8 ? 4 : 0, in[1] + 1 * D);
        add(in[11], (bf16*)(ws + W_AT_OUT), D, D, D, AT_FP8 ? 4 : 0);
        add(in[12], (bf16*)(ws + W_S5_IN), D, D, D, S5_FP8 ? 4 : 0);
        add(in[21], (bf16*)(ws + W_S5_OUT), D, D, 2048, 1 | (S5_FP8 ? 4 : 0));
        add(in[21] + D, (bf16*)(ws + W_S5_OUT), D, D, 2048, 2 | (S5_FP8 ? 4 : 0));
        for (int f = 0; f < 2; ++f) {
            add(in[22] + (size_t)f * D * FFD, (bf16*)(ws + W_FF_GU + f * SZ_FF_GU), D, FFD, FFD, 1 | (f ? 4 : 0), in[2] + 2 * f * D);
            add(in[23] + (size_t)f * D * FFD, (bf16*)(ws + W_FF_GU + f * SZ_FF_GU), D, FFD, FFD, 2 | (f ? 4 : 0), in[2] + 2 * f * D);
            add(in[24] + (size_t)f * FFD * D, (bf16*)(ws + W_FF_D + f * SZ_FF_D), FFD, D, D, 0 | (f ? 4 : 0));
        }
        for (int fe = 0; fe < 16; ++fe) {
            add(in[27] + (size_t)fe * D * FFE, (bf16*)(ws + W_MOE_GU + fe * SZ_MOE_GU), D, FFE, FFE, 1 | 4);
            add(in[28] + (size_t)fe * D * FFE, (bf16*)(ws + W_MOE_GU + fe * SZ_MOE_GU), D, FFE, FFE, 2 | 4);
            add(in[29] + (size_t)fe * FFE * D, (bf16*)(ws + W_MOE_D + fe * SZ_MOE_D), FFE, D, D, 0 | 4);
        }
        jobs[nj].item0 = it; *njobs_p = nj;
    }
    __syncthreads();
    const int nj = *njobs_p; const int total = jobs[nj].item0;
    const int e3 = total - CV_ABS1 - CV_ABS2, b3 = e3 - CV_ABS3;
    const int lo = part == 0 ? 0 : (part == 3 ? b3 : (part == 1 ? e3 : total - CV_ABS2)), hi = part == 0 ? b3 : (part == 3 ? e3 : (part == 1 ? total - CV_ABS2 : total));
    int j = 0;
    for (int it = lo + worker; it < hi; it += nworkers) {
        while (jobs[j + 1].item0 <= it) ++j;
        const float* src = jobs[j].src; bf16* dst = jobs[j].dst; const float* gain = jobs[j].gain; const int K = jobs[j].K, N = jobs[j].N, ldw = jobs[j].ldw, mode = jobs[j].mode, i0 = jobs[j].item0;
        if (mode & 4) tr_item8((const GAS float*)src, K, ldw, N / 64, (GAS unsigned char*)dst, mode & 3, 64.f, (LAS unsigned char*)scr, it - i0, C.lane, gain);
        else tr_item((const GAS float*)src, K, ldw, N / 64, (GAS bf16*)dst, mode, scr, it - i0, C.lane, gain);
    }
    __syncthreads();
}

__device__ __forceinline__ float log_sigmoid(float x) { return fminf(x, 0.f) - log1pf(__expf(-fabsf(x))); }
__device__ __forceinline__ float wave_sum8(const float (&p)[8], int lane) {
    float a[4], b[2], c0;
    { const bool hi = lane & 1;
#pragma unroll
      for (int i = 0; i < 4; ++i) { const float mine = hi ? p[4 + i] : p[i], give = hi ? p[i] : p[4 + i]; a[i] = mine + __shfl_xor(give, 1); } }
    { const bool hi = lane & 2;
#pragma unroll
      for (int i = 0; i < 2; ++i) { const float mine = hi ? a[2 + i] : a[i], give = hi ? a[i] : a[2 + i]; b[i] = mine + __shfl_xor(give, 2); } }
    { const bool hi = lane & 4; const float mine = hi ? b[1] : b[0], give = hi ? b[0] : b[1]; c0 = mine + __shfl_xor(give, 4); }
    c0 += __shfl_xor(c0, 8); c0 += __shfl_xor(c0, 16); c0 += __shfl_xor(c0, 32);
    return c0;
}
__device__ __forceinline__ int sum8_index(int lane) { return 4 * (lane & 1) + 2 * ((lane >> 1) & 1) + ((lane >> 2) & 1); }
__device__ __forceinline__ f32x4 ldx4(const bf16* row, int idx) { const v2u r = ((const v2u*)row)[idx]; return (f32x4){bflo(r.x), bfhi(r.x), bflo(r.y), bfhi(r.y)}; }
template <bool GATES, bool FP8OUT = false, bool XBF = true>
__device__ __forceinline__ void norm_phase(const Ctx& C, const void* xin_, const float* gain, bf16* out, const float* w_in, const float* b_if, float* gates_out) {
    f32x4 wg[GATES ? 32 : 1];
    if constexpr (GATES) {
#pragma unroll
        for (int j = 0; j < 4; ++j)
#pragma unroll
            for (int cc = 0; cc < 4; ++cc) { const float* wp = w_in + (size_t)(256 * j + 4 * C.lane + cc) * 3080 + 3072; wg[(4 * j + cc) * 2] = *(const f32x4*)wp; wg[(4 * j + cc) * 2 + 1] = *(const f32x4*)(wp + 4); }
    }
    const int gw = C.blk * NWAVES + C.wave, NGW = C.G * NWAVES;
    f32x4 g[4];
#pragma unroll
    for (int j = 0; j < 4; ++j) g[j] = ((const f32x4*)gain)[C.lane + 64 * j];
    const float* xin = (const float*)xin_; const bf16* xinb = (const bf16*)xin_;
    constexpr int PD = GATES ? (XBF ? 4 : 2) : (XBF ? 8 : 4);
    for (int m0 = gw; m0 < T; m0 += NGW * PD) {
      v2u rb[XBF ? PD : 1][4]; f32x4 rf[XBF ? 1 : PD][4];
#pragma unroll
      for (int r = 0; r < PD; ++r) { const int mr = m0 + r * NGW;
        if (mr < T) {
            if constexpr (XBF) {
#pragma unroll
                for (int j = 0; j < 4; ++j) rb[r][j] = ((const v2u*)(xinb + (size_t)mr * D))[C.lane + 64 * j];
            } else { const f32x4* xr = (const f32x4*)(xin + (size_t)mr * D) + C.lane;
#pragma unroll
                for (int j = 0; j < 4; ++j) rf[r][j] = xr[64 * j]; } } }
#pragma unroll
      for (int r = 0; r < PD; ++r) { const int m = m0 + r * NGW;
       if (m < T) {
        f32x4 v[4]; float ss = 0.f;
#pragma unroll
        for (int j = 0; j < 4; ++j) { if constexpr (XBF) v[j] = (f32x4){bflo(rb[r][j].x), bfhi(rb[r][j].x), bflo(rb[r][j].y), bfhi(rb[r][j].y)}; else v[j] = rf[r][j]; }
#pragma unroll
        for (int j = 0; j < 4; ++j) ss += (v[j].x * v[j].x + v[j].y * v[j].y) + (v[j].z * v[j].z + v[j].w * v[j].w);
        const float inv = rsqrtf(wave_sum(ss) * (1.f / D) + EPS);
        if constexpr (FP8OUT) { unsigned* o4 = (unsigned*)((unsigned char*)out + (size_t)m * D) + C.lane;
#pragma unroll
            for (int j = 0; j < 4; ++j) { v[j] = v[j] * inv * g[j]; o4[64 * j] = pg8::cvt4_fp8(v[j].x, v[j].y, v[j].z, v[j].w); }
        } else { unsigned long long* o8 = (unsigned long long*)(out + (size_t)m * D) + C.lane;
#pragma unroll
            for (int j = 0; j < 4; ++j) { v[j] = v[j] * inv * g[j]; o8[64 * j] = (unsigned long long)pk2(v[j].x, v[j].y) | ((unsigned long long)pk2(v[j].z, v[j].w) << 32); } }
        if constexpr (GATES) {
            float p[8];
#pragma unroll
            for (int i = 0; i < 8; ++i) p[i] = 0.f;
#pragma unroll
            for (int j = 0; j < 4; ++j)
#pragma unroll
                for (int c = 0; c < 4; ++c) { const f32x4 w0 = wg[(4 * j + c) * 2], w1 = wg[(4 * j + c) * 2 + 1]; const float h = v[j][c];
                    p[0] += h * w0.x; p[1] += h * w0.y; p[2] += h * w0.z; p[3] += h * w0.w; p[4] += h * w1.x; p[5] += h * w1.y; p[6] += h * w1.z; p[7] += h * w1.w; }
            const float tot = wave_sum8(p, C.lane); const int ln = pg8::lane_asm(); const int gi = sum8_index(ln);
            if (ln < 8) { float val = tot + b_if[gi]; if (gi >= 4) val = log_sigmoid(val); gates_out[(size_t)m * 8 + gi] = val; }
        }
       } }
    }
}

__device__ __forceinline__ float wave_incl_scan_add(float v, int lane) {
#pragma unroll
    for (int o = 1; o < 64; o <<= 1) { const float t = __shfl_up(v, o); if (lane >= o) v += t; }
    return v;
}
__device__ __forceinline__ float wave_incl_scan_max(float v, int lane) {
#pragma unroll
    for (int o = 1; o < 64; o <<= 1) { const float t = __shfl_up(v, o); if (lane >= o) v = fmaxf(v, t); }
    return v;
}
__device__ __forceinline__ void ml_m1(const Ctx& C, const bf16* PROJ, const float* gates, const float* convw, bf16* QKC, bf16* PL, bf16* GT, float* NLOC, float* NT,
                                      float* MPREV, float* DELTA, float* DG) {
    LAS bf16* Kn = (LAS bf16*)(C.lds);
    LAS bf16* Vn = (LAS bf16*)(C.lds + 17408);
    LAS float* wk = (LAS float*)(C.lds + 51200);
    LAS float* BtL = wk + 64; LAS float* PtL = wk + 128; LAS float* decL = wk + 192; LAS float* mprevL = wk + 256; LAS float* mxL = wk + 320;
    const int cg = C.tid & 31, s_base = C.tid >> 5; const bool isk = cg >= 16;
    const int r16 = C.lane & 15, q4 = C.lane >> 4;
    v4u praw[7], vraw[4]; float ig_ = 0.f, lf_ = 0.f;
    LAS f32x4* cwL = (LAS f32x4*)(C.lds + 53248);
#define M1_ISSUE(uu) do { const int bh_ = (uu) >> 6, c_ = (uu) & 63, b_ = bh_ >> 2, h_ = bh_ & 3; const int t0_ = b_ * SEQ + c_ * 64; \
        const int col_ = isk ? (512 + h_ * 128 + (cg - 16) * 8) : (h_ * 128 + cg * 8); \
        _Pragma("unroll") for (int r_ = 0; r_ < 7; ++r_) { const int sp_ = c_ * 64 + 4 * s_base - 3 + r_; \
            praw[r_] = (sp_ >= 0) ? *(const v4u*)(PROJ + (size_t)(b_ * SEQ + sp_) * 3072 + col_) : (v4u){0u, 0u, 0u, 0u}; } \
        _Pragma("unroll") for (int i_ = 0; i_ < 4; ++i_) vraw[i_] = *(const v4u*)(PROJ + (size_t)(t0_ + s_base + 16 * i_) * 3072 + 1024 + h_ * 256 + cg * 8); \
        if (C.wave == 0) { ig_ = gates[(size_t)(t0_ + C.lane) * 8 + h_]; lf_ = gates[(size_t)(t0_ + C.lane) * 8 + 4 + h_]; } } while (0)
    for (int gu = C.blk; gu < 256; gu += C.G) {
        const int bh = gu >> 4, gq = gu & 15, b = bh >> 2, h = bh & 3;
        M1_ISSUE(bh * 64 + 4 * gq);
        if (s_base == 0) { const int colw = isk ? (512 + h * 128 + (cg - 16) * 8) : (h * 128 + cg * 8);
#pragma unroll
            for (int jj = 0; jj < 4; ++jj) { cwL[cg * 8 + 2 * jj] = *(const f32x4*)(convw + jj * 1024 + colw); cwL[cg * 8 + 2 * jj + 1] = *(const f32x4*)(convw + jj * 1024 + colw + 4); } }
#pragma unroll 1
        for (int i = 0; i < 8; ++i) { const int cc = C.wave * 8 + i; const int tt = b * SEQ + cc * 64 + C.lane;
            const float ig = gates[(size_t)tt * 8 + h], lf = gates[(size_t)tt * 8 + 4 + h];
            const float bc = wave_incl_scan_add(lf, C.lane); const float P = wave_max(ig - bc); const float B = __shfl(bc, 63);
            if (C.lane == 0) { BtL[cc] = B; PtL[cc] = P; } }
        __syncthreads();
        if (C.tid == 0) { float m = 0.f;
            for (int cc = 0; cc < 64; ++cc) { const float mx = fmaxf(m, PtL[cc]); mprevL[cc] = m; mxL[cc] = mx; decL[cc] = __expf(m - mx); m = BtL[cc] + mx; } }
        __syncthreads();
        f32x4 acc[16];
#pragma unroll
        for (int t = 0; t < 16; ++t) acc[t] = (f32x4){0.f, 0.f, 0.f, 0.f};
        float nacc = 0.f, delta = 1.f;
#pragma unroll 1
        for (int i = 0; i < 4; ++i) {
            int c = 4 * gq + i; asm volatile("" : "+s"(c));
            const int u = bh * 64 + c; const int t0 = b * SEQ + c * 64;
            const int col = isk ? (512 + h * 128 + (cg - 16) * 8) : (h * 128 + cg * 8);
            if (C.wave == 0) {
                const float bc = wave_incl_scan_add(lf_, C.lane); const float a = ig_ - bc;
                wk[C.lane] = __expf(a - mxL[c]);
                if (C.lane == 0) { MPREV[u] = mprevL[c]; DELTA[u] = delta; }
            }
#pragma unroll
            for (int k = 0; k < 4; ++k) *(LAS v4u*)(Vn + (s_base + 16 * k) * 264 + cg * 8) = vraw[k];
            __syncthreads();
#pragma unroll
            for (int k = 0; k < 4; ++k) { const int s = 4 * s_base + k;
                float cv[8];
#pragma unroll
                for (int e = 0; e < 8; ++e) cv[e] = 0.f;
#pragma unroll
                for (int jj = 0; jj < 4; ++jj) { const v4u raw = praw[k + jj]; const f32x4 w0 = cwL[cg * 8 + 2 * jj], w1 = cwL[cg * 8 + 2 * jj + 1];
                    cv[0] += bflo(raw.x) * w0.x; cv[1] += bfhi(raw.x) * w0.y; cv[2] += bflo(raw.y) * w0.z; cv[3] += bfhi(raw.y) * w0.w;
                    cv[4] += bflo(raw.z) * w1.x; cv[5] += bfhi(raw.z) * w1.y; cv[6] += bflo(raw.w) * w1.z; cv[7] += bfhi(raw.w) * w1.w; }
                const float sc = isk ? 0.08838834764831845f : 1.0f;
#pragma unroll
                for (int e = 0; e < 8; ++e) cv[e] = cv[e] * sigmoidf_(cv[e]) * sc;
                v4u o; o.x = pk2(cv[0], cv[1]); o.y = pk2(cv[2], cv[3]); o.z = pk2(cv[4], cv[5]); o.w = pk2(cv[6], cv[7]);
                *(v4u*)(QKC + (size_t)(t0 + s) * 1024 + col) = o;
                if (isk) { const float w = wk[s]; v4u ow; ow.x = pk2(cv[0] * w, cv[1] * w); ow.y = pk2(cv[2] * w, cv[3] * w); ow.z = pk2(cv[4] * w, cv[5] * w); ow.w = pk2(cv[6] * w, cv[7] * w);
                    *(LAS v4u*)(Kn + s * 136 + (cg - 16) * 8) = ow; } }
            if (i > 0) { bf16* pl = PL + (size_t)u * 32768 + C.wave * 16 + 4 * q4;
#pragma unroll
              for (int t = 0; t < 16; ++t) *(v2u*)(pl + (t * 16 + r16) * 128) = pack4(acc[t]); }
            if (C.tid < 128) NLOC[(size_t)u * 128 + C.tid] = nacc;
            __syncthreads();
            const float d = decL[c];
#pragma unroll
            for (int t = 0; t < 16; ++t) acc[t] *= d;
#pragma unroll
            for (int k = 0; k < 64; k += 32) { const bf16x8 a = ldfrag<true>(Kn, 136, C.wave * 16, k, C.lane);
#pragma unroll
                for (int t4 = 0; t4 < 16; t4 += 4) {
                    bf16x8 bq[4];
#pragma unroll
                    for (int t = 0; t < 4; ++t) bq[t] = ldfrag<true>(Vn, 264, (t4 + t) * 16, k, C.lane);
#pragma unroll
                    for (int t = 0; t < 4; ++t) acc[t4 + t] = __builtin_amdgcn_mfma_f32_16x16x32_bf16(a, bq[t], acc[t4 + t], 0, 0, 0);
                    __builtin_amdgcn_sched_barrier(0); } }
            if (C.tid < 128) { float sm = 0.f;
#pragma unroll 16
                for (int k = 0; k < 64; ++k) sm += bf2f(Kn[k * 136 + C.tid]);
                nacc = d * nacc + sm; }
            delta *= d;
            if (i + 1 < 4) M1_ISSUE(u + 1);
            __syncthreads();
        }
        { const int ln = pg8::lane_asm();
          bf16* gt = GT + (size_t)gu * 32768 + C.wave * 16 + 4 * (ln >> 4);
#pragma unroll
          for (int t = 0; t < 16; ++t) *(v2u*)(gt + (t * 16 + (ln & 15)) * 128) = pack4(acc[t]); }
        if (C.tid < 128) NT[(size_t)gu * 128 + C.tid] = nacc;
        if (C.tid == 0) DG[gu] = delta;
        __syncthreads();
    }
#undef M1_ISSUE
}
__device__ __forceinline__ void ml_m2(const Ctx& C, const bf16* GT, bf16* GS, const float* NT, float* NSg, const float* DG) {
    for (int wi = C.blk; wi < 256; wi += C.G) {
        const int bh = wi >> 4, slice = wi & 15;
        const size_t e0 = (size_t)slice * 2048 + (size_t)C.tid * 4;
        float dg[16]; v2u raw[16];
#pragma unroll
        for (int g = 0; g < 16; ++g) { dg[g] = DG[bh * 16 + g]; raw[g] = *(const v2u*)(GT + (size_t)(bh * 16 + g) * 32768 + e0); }
        float c0 = 0.f, c1 = 0.f, c2 = 0.f, c3 = 0.f;
#pragma unroll
        for (int g = 0; g < 16; ++g) { v2u o; o.x = pk2(c0, c1); o.y = pk2(c2, c3); *(v2u*)(GS + (size_t)(bh * 16 + g) * 32768 + e0) = o;
            const float d = dg[g];
            c0 = d * c0 + bflo(raw[g].x); c1 = d * c1 + bfhi(raw[g].x); c2 = d * c2 + bflo(raw[g].y); c3 = d * c3 + bfhi(raw[g].y); }
        if (slice == 0 && C.tid < 128) { float n = 0.f;
#pragma unroll
            for (int g = 0; g < 16; ++g) { NSg[(size_t)(bh * 16 + g) * 128 + C.tid] = n; n = dg[g] * n + NT[(size_t)(bh * 16 + g) * 128 + C.tid]; } }
    }
}
__device__ __forceinline__ v4u comb8(v4u p, v4u g, float d) {
    v4u o; o.x = pk2(bflo(p.x) + d * bflo(g.x), bfhi(p.x) + d * bfhi(g.x)); o.y = pk2(bflo(p.y) + d * bflo(g.y), bfhi(p.y) + d * bfhi(g.y));
    o.z = pk2(bflo(p.z) + d * bflo(g.z), bfhi(p.z) + d * bfhi(g.z)); o.w = pk2(bflo(p.w) + d * bflo(g.w), bfhi(p.w) + d * bfhi(g.w)); return o; }
template <bool G8>
__device__ __forceinline__ void ml_m3(const Ctx& C, const bf16* QKC, const bf16* PROJ, const bf16* PL, const bf16* GS, const float* NLOC, const float* NSg, const float* MPREV, const float* DELTA,
                                      const float* gates, const float* head_gain, bf16* Gout) {
    LAS bf16* Qs = (LAS bf16*)(C.lds);
    LAS bf16* HB = (LAS bf16*)(C.lds + 17408);
    LAS bf16* Ks = HB;
    LAS bf16* Pm = (LAS bf16*)(C.lds + 51200);
    LAS bf16* Vn = (LAS bf16*)(C.lds + 60416);
    LAS bf16* Ct = (LAS bf16*)(C.lds + 77824);
    LAS float* aL = (LAS float*)(C.lds + 112640); LAS float* mxL = aL + 64; LAS float* winL = aL + 128; LAS float* rdenL = aL + 192; LAS float* emtL = aL + 256; LAS float* nprevL = aL + 320;
    const int r4 = C.tid >> 4, pc = C.tid & 15;
    v4u qk[4], vh0[2], ch0[4], gs0[4], vh1[2], ch1[4], gs1[4], og[4]; float ig_ = 0.f, lf_ = 0.f, mp_ = 0.f, np_ = 0.f, dl_ = 0.f;
#define M3_ISSUE_A(uu) do { const int bh_ = (uu) >> 6, c_ = (uu) & 63, b_ = bh_ >> 2, h_ = bh_ & 3; const int t0_ = b_ * SEQ + c_ * 64; \
        _Pragma("unroll") for (int i_ = 0; i_ < 4; ++i_) qk[i_] = *(const v4u*)(QKC + (size_t)(t0_ + r4 + 32 * (i_ & 1)) * 1024 + (i_ >> 1) * 512 + h_ * 128 + pc * 8); \
        _Pragma("unroll") for (int i_ = 0; i_ < 2; ++i_) vh0[i_] = *(const v4u*)(PROJ + (size_t)(t0_ + r4 + 32 * i_) * 3072 + 1024 + h_ * 256 + pc * 8); \
        const int gi_ = bh_ * 16 + (c_ >> 2); dl_ = DELTA[(uu)]; \
        _Pragma("unroll") for (int i_ = 0; i_ < 4; ++i_) { ch0[i_] = (c_ & 3) ? *(const v4u*)(PL + (size_t)(uu) * 32768 + (size_t)(r4 + 32 * i_) * 128 + pc * 8) : (v4u){0u, 0u, 0u, 0u};   gs0[i_] = *(const v4u*)(GS + (size_t)gi_ * 32768 + (size_t)(r4 + 32 * i_) * 128 + pc * 8); } \
        if (C.wave == 0) { ig_ = gates[(size_t)(t0_ + C.lane) * 8 + h_]; lf_ = gates[(size_t)(t0_ + C.lane) * 8 + 4 + h_]; mp_ = MPREV[(uu)]; } \
        if (C.tid >= 64 && C.tid < 192) np_ = NLOC[(size_t)(uu) * 128 + C.tid - 64] + dl_ * NSg[(size_t)gi_ * 128 + C.tid - 64]; } while (0)
    const int upw = 1024 / C.G;
    int u = C.blk * upw; const int uend = u + upw;
    M3_ISSUE_A(u);
    for (; u < uend; ++u) {
        const int bh = u >> 6, c = u & 63, b = bh >> 2, h = bh & 3; const int t0 = b * SEQ + c * 64;
#pragma unroll
        for (int i = 0; i < 4; ++i) *(LAS v4u*)(((i >> 1) ? Ks : Qs) + (r4 + 32 * (i & 1)) * 136 + pc * 8) = qk[i];
#pragma unroll
        for (int i = 0; i < 2; ++i) *(LAS v4u*)(Vn + (r4 + 32 * i) * 136 + pc * 8) = vh0[i];
        const float dl = dl_; const int gi = bh * 16 + (c >> 2);
#pragma unroll
        for (int i = 0; i < 4; ++i) *(LAS v4u*)(Ct + (r4 + 32 * i) * 136 + pc * 8) = comb8(ch0[i], gs0[i], dl);
        if (C.wave == 0) {
            const float bc = wave_incl_scan_add(lf_, C.lane); const float a = ig_ - bc; const float pm = wave_incl_scan_max(a, C.lane);
            const float mx = fmaxf(mp_, pm); const float mt = bc + mx;
            aL[C.lane] = a; mxL[C.lane] = mx; winL[C.lane] = __expf(mp_ - mx); emtL[C.lane] = __expf(-mt);
        }
        if (C.tid >= 64 && C.tid < 192) nprevL[C.tid - 64] = np_;
#pragma unroll
        for (int i = 0; i < 2; ++i) vh1[i] = *(const v4u*)(PROJ + (size_t)(t0 + r4 + 32 * i) * 3072 + 1024 + h * 256 + 128 + pc * 8);
#pragma unroll
        for (int i = 0; i < 4; ++i) { ch1[i] = (c & 3) ? *(const v4u*)(PL + (size_t)u * 32768 + (size_t)(128 + r4 + 32 * i) * 128 + pc * 8) : (v4u){0u, 0u, 0u, 0u}; gs1[i] = *(const v4u*)(GS + (size_t)gi * 32768 + (size_t)(128 + r4 + 32 * i) * 128 + pc * 8); }
        { const int row = C.tid >> 3, sub = C.tid & 7;
#pragma unroll
          for (int g8 = 0; g8 < 4; ++g8) og[g8] = *(const v4u*)(PROJ + (size_t)(t0 + row) * 3072 + 2048 + h * 256 + sub * 32 + g8 * 8); }
        __syncthreads();
        lds_mmx<64, 64, 128, false, false, 0, 4>(Ks, 136, Qs, 136, Ks, 136, Qs, 136, C.wave, C.lane, [=](int s0, int t, f32x4 v) {
            const float mxt = mxL[t]; f32x4 p;
#pragma unroll
            for (int j = 0; j < 4; ++j) p[j] = (s0 + j <= t) ? v[j] * __expf(aL[s0 + j] - mxt) : 0.f;
            *(LAS v2u*)(Pm + t * 72 + s0) = pack4(p); });
        __syncthreads();
        { const int t = C.tid >> 3, sub = C.tid & 7; float s1 = 0.f, s2 = 0.f;
          const v4u pr = *(const LAS v4u*)(Pm + t * 72 + sub * 8);
          s1 = (bflo(pr.x) + bfhi(pr.x)) + (bflo(pr.y) + bfhi(pr.y)) + (bflo(pr.z) + bfhi(pr.z)) + (bflo(pr.w) + bfhi(pr.w));
#pragma unroll
          for (int hh = 0; hh < 2; ++hh) { const v4u qr = *(const LAS v4u*)(Qs + t * 136 + sub * 16 + hh * 8); const LAS float* np = nprevL + sub * 16 + hh * 8;
              s2 += bflo(qr.x) * np[0] + bfhi(qr.x) * np[1] + bflo(qr.y) * np[2] + bfhi(qr.y) * np[3] + bflo(qr.z) * np[4] + bfhi(qr.z) * np[5] + bflo(qr.w) * np[6] + bfhi(qr.w) * np[7]; }
          s1 += __shfl_xor(s1, 1); s1 += __shfl_xor(s1, 2); s1 += __shfl_xor(s1, 4); s2 += __shfl_xor(s2, 1); s2 += __shfl_xor(s2, 2); s2 += __shfl_xor(s2, 4);
          if (sub == 0) { const float den = s1 + winL[t] * s2; rdenL[t] = __builtin_amdgcn_rcpf(fmaxf(fabsf(den), emtL[t])); } }
        __syncthreads();
        lds_mmx2<128, 64, 64, true, 128, 4>(Vn, 136, Pm, 72, Ct, 136, Qs, 136, C.wave, C.lane, [=](int dv0, int t, f32x4 v1, f32x4 v2) {
            *(LAS v2u*)(HB + t * 264 + dv0) = pack4((v1 + v2 * winL[t]) * rdenL[t]); });
        __syncthreads();
#pragma unroll
        for (int i = 0; i < 2; ++i) *(LAS v4u*)(Vn + (r4 + 32 * i) * 136 + pc * 8) = vh1[i];
#pragma unroll
        for (int i = 0; i < 4; ++i) *(LAS v4u*)(Ct + (r4 + 32 * i) * 136 + pc * 8) = comb8(ch1[i], gs1[i], dl);
        if (u + 1 < uend) M3_ISSUE_A(u + 1);
        __syncthreads();
        lds_mmx2<128, 64, 64, true, 128, 4>(Vn, 136, Pm, 72, Ct, 136, Qs, 136, C.wave, C.lane, [=](int dv0, int t, f32x4 v1, f32x4 v2) {
            *(LAS v2u*)(HB + t * 264 + 128 + dv0) = pack4((v1 + v2 * winL[t]) * rdenL[t]); });
        __syncthreads();
        { const int row = C.tid >> 3, sub = C.tid & 7; float ss = 0.f; v4u hr[4];
#pragma unroll
          for (int g8 = 0; g8 < 4; ++g8) { hr[g8] = *(const LAS v4u*)(HB + row * 264 + sub * 32 + g8 * 8);
              ss += bflo(hr[g8].x) * bflo(hr[g8].x) + bfhi(hr[g8].x) * bfhi(hr[g8].x) + bflo(hr[g8].y) * bflo(hr[g8].y) + bfhi(hr[g8].y) * bfhi(hr[g8].y)
                  + bflo(hr[g8].z) * bflo(hr[g8].z) + bfhi(hr[g8].z) * bfhi(hr[g8].z) + bflo(hr[g8].w) * bflo(hr[g8].w) + bfhi(hr[g8].w) * bfhi(hr[g8].w); }
          ss += __shfl_xor(ss, 1); ss += __shfl_xor(ss, 2); ss += __shfl_xor(ss, 4);
          const float inv = rsqrtf(ss * (1.f / 256.f) + EPS);
#pragma unroll
          for (int g8 = 0; g8 < 4; ++g8) { const int col = sub * 32 + g8 * 8; const v4u oraw = og[g8];
              const f32x4 g0 = *(const f32x4*)(head_gain + h * 256 + col), g1 = *(const f32x4*)(head_gain + h * 256 + col + 4);
              float hv[8];
              hv[0] = bflo(hr[g8].x) * inv * g0.x * sigmoidf_(bflo(oraw.x)); hv[1] = bfhi(hr[g8].x) * inv * g0.y * sigmoidf_(bfhi(oraw.x));
              hv[2] = bflo(hr[g8].y) * inv * g0.z * sigmoidf_(bflo(oraw.y)); hv[3] = bfhi(hr[g8].y) * inv * g0.w * sigmoidf_(bfhi(oraw.y));
              hv[4] = bflo(hr[g8].z) * inv * g1.x * sigmoidf_(bflo(oraw.z)); hv[5] = bfhi(hr[g8].z) * inv * g1.y * sigmoidf_(bfhi(oraw.z));
              hv[6] = bflo(hr[g8].w) * inv * g1.z * sigmoidf_(bflo(oraw.w)); hv[7] = bfhi(hr[g8].w) * inv * g1.w * sigmoidf_(bfhi(oraw.w));
              if constexpr (G8) { v2u o8; o8.x = pg8::cvt4_fp8(hv[0], hv[1], hv[2], hv[3]); o8.y = pg8::cvt4_fp8(hv[4], hv[5], hv[6], hv[7]);
                  *(v2u*)((unsigned char*)Gout + (size_t)(t0 + row) * 1024 + h * 256 + col) = o8; }
              else { v4u o; o.x = pk2(hv[0], hv[1]); o.y = pk2(hv[2], hv[3]); o.z = pk2(hv[4], hv[5]); o.w = pk2(hv[6], hv[7]);
                  *(v4u*)(Gout + (size_t)(t0 + row) * 1024 + h * 256 + col) = o; } } }
        __syncthreads();
    }
#undef M3_ISSUE_A
}

template <bool G8>
__device__ __forceinline__ void attn_phase(const Ctx& C, const bf16* QKV, const float* rel_bias, bf16* Gout) {
    LAS bf16* KV = (LAS bf16*)(C.lds);
    LAS float* bt = (LAS float*)(C.lds + 36864);
    const int r16 = C.lane & 15, g = C.lane >> 4, qt = (C.lane & 15) >> 2, pt = C.lane & 3;
    const int sr = C.tid >> 3, spc = C.tid & 7;
    for (int u = C.blk; u < 1024; u += C.G) {
        int bhh, cq;
        if (C.G == 256) { const int rnd = u >> 8, xcd = C.blk & 7, r = C.blk >> 3; bhh = rnd * 16 + xcd * 2 + (r >> 4); cq = r & 15; } else { bhh = u >> 4; cq = u & 15; }
        const int b = bhh >> 4, h = bhh & 15;
        const int myc = 4 * cq + (C.wave >> 1);
        const int qin = (C.wave & 1) * 32 + r16;
        const size_t qrow = (size_t)b * SEQ + myc * 64 + qin;
        bf16x8 qf[2][2];
#pragma unroll
        for (int q2 = 0; q2 < 2; ++q2) { qf[q2][0] = *(const bf16x8*)(QKV + (qrow + 16 * q2) * 3072 + h * 64 + 8 * g); qf[q2][1] = *(const bf16x8*)(QKV + (qrow + 16 * q2) * 3072 + h * 64 + 32 + 8 * g); }
        if (C.tid < 257) bt[C.tid] = (rel_bias[h * 257 + C.tid] - rel_bias[h * 257]) * 1.4426950408889634f;
        const int kc_lo = (4 * cq - 8) > 0 ? (4 * cq - 8) : 0, kc_hi = 4 * cq + 3, nt = kc_hi - kc_lo + 1;
        { const size_t krow = (size_t)b * SEQ + kc_lo * 64 + sr;
          const v4u kr0 = *(const v4u*)(QKV + krow * 3072 + 1024 + h * 64 + spc * 8), vr0 = *(const v4u*)(QKV + krow * 3072 + 2048 + h * 64 + spc * 8);
          *(LAS v4u*)(KV + sr * 72 + spc * 8) = kr0; *(LAS v4u*)(KV + 4608 + sr * 72 + spc * 8) = vr0; }
        v4u kr = {0u, 0u, 0u, 0u}, vr = {0u, 0u, 0u, 0u};
        if (nt > 1) { const size_t krow = (size_t)b * SEQ + (kc_lo + 1) * 64 + sr;
            kr = *(const v4u*)(QKV + krow * 3072 + 1024 + h * 64 + spc * 8); vr = *(const v4u*)(QKV + krow * 3072 + 2048 + h * 64 + spc * 8); }
        __syncthreads();
        float m[2] = {-1e30f, -1e30f}; f32x4 O[2][4], L[2] = {{0.f, 0.f, 0.f, 0.f}, {0.f, 0.f, 0.f, 0.f}};
        const bf16x8 ones = {0x3F80, 0x3F80, 0x3F80, 0x3F80, 0x3F80, 0x3F80, 0x3F80, 0x3F80};
#pragma unroll
        for (int q2 = 0; q2 < 2; ++q2)
#pragma unroll
            for (int d = 0; d < 4; ++d) O[q2][d] = (f32x4){0.f, 0.f, 0.f, 0.f};
        for (int j = 0; j < nt; ++j) {
            const int kc = kc_lo + j; const bool more = (j + 1 < nt);
            v4u kr2 = {0u, 0u, 0u, 0u}, vr2 = {0u, 0u, 0u, 0u};
            if (j + 2 < nt) { const size_t krow = (size_t)b * SEQ + (kc + 2) * 64 + sr;
                kr2 = *(const v4u*)(QKV + krow * 3072 + 1024 + h * 64 + spc * 8); vr2 = *(const v4u*)(QKV + krow * 3072 + 2048 + h * 64 + spc * 8); }
            if (kc >= myc - 8 && kc <= myc) {
                const LAS bf16* Kb = KV + (j & 1) * 9216; const LAS bf16* Vb = Kb + 4608;
                f32x4 S[2][4];
#pragma unroll
                for (int kt = 0; kt < 4; ++kt) { S[0][kt] = (f32x4){0.f, 0.f, 0.f, 0.f}; S[1][kt] = (f32x4){0.f, 0.f, 0.f, 0.f};
#pragma unroll
                    for (int kk = 0; kk < 2; ++kk) { const bf16x8 kf = *(const LAS bf16x8*)(Kb + (16 * kt + r16) * 72 + 32 * kk + 8 * g);
                        S[0][kt] = __builtin_amdgcn_mfma_f32_16x16x32_bf16(kf, qf[0][kk], S[0][kt], 0, 0, 0);
                        S[1][kt] = __builtin_amdgcn_mfma_f32_16x16x32_bf16(kf, qf[1][kk], S[1][kt], 0, 0, 0); } }
                bf16x8 pf[2][2];
#pragma unroll
                for (int q2 = 0; q2 < 2; ++q2) {
                    if (kc >= myc - 2) { const int relb = (kc - myc) * 64 - (qin + 16 * q2) + 4 * g + 128;
#pragma unroll
                        for (int kt = 0; kt < 4; ++kt)
#pragma unroll
                            for (int jj = 0; jj < 4; ++jj) { int idx = relb + 16 * kt + jj; idx = idx < 0 ? 0 : (idx > 256 ? 256 : idx); S[q2][kt][jj] += bt[idx]; }
                    }
                    float tm = fmaxf(fmaxf(S[q2][0][0], S[q2][0][1]), fmaxf(S[q2][0][2], S[q2][0][3]));
#pragma unroll
                    for (int kt = 1; kt < 4; ++kt) tm = fmaxf(tm, fmaxf(fmaxf(S[q2][kt][0], S[q2][kt][1]), fmaxf(S[q2][kt][2], S[q2][kt][3])));
                    tm = fmaxf(tm, __shfl_xor(tm, 16)); tm = fmaxf(tm, __shfl_xor(tm, 32));
                    const float mn = fmaxf(m[q2], tm); const float alpha = __builtin_amdgcn_exp2f(m[q2] - mn); m[q2] = mn;
#pragma unroll
                    for (int kt = 0; kt < 4; ++kt)
#pragma unroll
                        for (int jj = 0; jj < 4; ++jj) S[q2][kt][jj] = __builtin_amdgcn_exp2f(S[q2][kt][jj] - mn);
                    L[q2] *= alpha;
#pragma unroll
                    for (int d = 0; d < 4; ++d) O[q2][d] *= alpha;
#pragma unroll
                    for (int ks = 0; ks < 2; ++ks) { v4u w; w.x = pk2(S[q2][2 * ks][0], S[q2][2 * ks][1]); w.y = pk2(S[q2][2 * ks][2], S[q2][2 * ks][3]);
                        w.z = pk2(S[q2][2 * ks + 1][0], S[q2][2 * ks + 1][1]); w.w = pk2(S[q2][2 * ks + 1][2], S[q2][2 * ks + 1][3]); pf[q2][ks] = __builtin_bit_cast(bf16x8, w); }
                }
#pragma unroll
                for (int d = 0; d < 4; ++d)
#pragma unroll
                    for (int ks = 0; ks < 2; ++ks) { const s16x4 v0 = lds_tr16(Vb + (32 * ks + 4 * g + qt) * 72 + 16 * d + 4 * pt), v1 = lds_tr16(Vb + (32 * ks + 16 + 4 * g + qt) * 72 + 16 * d + 4 * pt);
                        const bf16x8 vf = {v0[0], v0[1], v0[2], v0[3], v1[0], v1[1], v1[2], v1[3]};
                        O[0][d] = __builtin_amdgcn_mfma_f32_16x16x32_bf16(vf, pf[0][ks], O[0][d], 0, 0, 0);
                        O[1][d] = __builtin_amdgcn_mfma_f32_16x16x32_bf16(vf, pf[1][ks], O[1][d], 0, 0, 0); }
#pragma unroll
                for (int ks = 0; ks < 2; ++ks) { L[0] = __builtin_amdgcn_mfma_f32_16x16x32_bf16(ones, pf[0][ks], L[0], 0, 0, 0); L[1] = __builtin_amdgcn_mfma_f32_16x16x32_bf16(ones, pf[1][ks], L[1], 0, 0, 0); }
            }
            if (more) { LAS bf16* Kn = KV + ((j + 1) & 1) * 9216; *(LAS v4u*)(Kn + sr * 72 + spc * 8) = kr; *(LAS v4u*)(Kn + 4608 + sr * 72 + spc * 8) = vr; }
            kr = kr2; vr = vr2;
            __syncthreads();
        }
#pragma unroll
        for (int q2 = 0; q2 < 2; ++q2) { const float il = __builtin_amdgcn_rcpf(L[q2][0]);
#pragma unroll
            for (int d = 0; d < 4; ++d) { const f32x4 o = O[q2][d] * il;
                if constexpr (G8) *(unsigned*)((unsigned char*)Gout + (qrow + 16 * q2) * 1024 + h * 64 + 16 * d + 4 * g) = pg8::cvt4_fp8(o[0], o[1], o[2], o[3]);
                else { v2u w; w.x = pk2(o[0], o[1]); w.y = pk2(o[2], o[3]); *(v2u*)(Gout + (qrow + 16 * q2) * 1024 + h * 64 + 16 * d + 4 * g) = w; } } }
        __syncthreads();
    }
}

__device__ __forceinline__ float gelu_tanh(float y) { return y * sigmoidf_(1.5957691216057308f * (y + 0.044715f * y * y * y)); }
__device__ __forceinline__ void s5_phase(const Ctx& C, const float* U32, const float* lam_re, const float* lam_im, const float* log_dt, const float* b_re, const float* b_im,
                                         const float* c_re, const float* c_im, const float* dskip, bf16* YG) {
    LAS bf16* BuT = (LAS bf16*)(C.lds);
    LAS bf16* Ub = (LAS bf16*)(C.lds + 67584);
    LAS float* uL = (LAS float*)(C.lds + 88064);
    LAS bf16* BBm = (LAS bf16*)(C.lds + 104448);
    LAS bf16* Cm = (LAS bf16*)(C.lds + 114688);
    LAS float* xend = (LAS float*)(C.lds + 119040);
    for (int u = C.blk; u < 256; u += C.G) {
        const int g = u >> 2, b = u & 3; const int n = C.lane;
        const float lr = lam_re[g * 64 + n], li = lam_im[g * 64 + n], dt = expf(log_dt[g]);
        const float mag = expf(lr * dt), ang = li * dt; const float ar = mag * cosf(ang), ai = mag * sinf(ang);
        const float mag32 = expf(32.f * lr * dt), ang32 = 32.f * ang; const float a32r = mag32 * cosf(ang32), a32i = mag32 * sinf(ang32);
        if (C.wave == 0) {
            const float den = lr * lr + li * li, nr = ar - 1.0f; const float zr = (nr * lr + ai * li) / den, zi = (ai * lr - nr * li) / den;
#pragma unroll
            for (int q = 0; q < 16; ++q) { const float br = b_re[(size_t)(g * 64 + n) * 16 + q], bi = b_im[(size_t)(g * 64 + n) * 16 + q];
                BBm[n * 40 + q] = (bf16)f2bf(zr * br - zi * bi); BBm[(64 + n) * 40 + q] = (bf16)f2bf(zr * bi + zi * br); }
        }
        for (int idx = C.tid; idx < 128 * 16; idx += NTHR) BBm[(idx >> 4) * 40 + 16 + (idx & 15)] = 0;
        for (int idx = C.tid; idx < 256 * 16; idx += NTHR) Ub[(idx >> 4) * 40 + 16 + (idx & 15)] = 0;
        for (int idx = C.tid; idx < 1024; idx += NTHR) { const int p = idx >> 6, nn = idx & 63;
            Cm[p * 136 + nn] = (bf16)f2bf(c_re[(size_t)(g * 16 + p) * 64 + nn]); Cm[p * 136 + 64 + nn] = (bf16)f2bf(-c_im[(size_t)(g * 16 + p) * 64 + nn]); }
        const int sr = C.tid >> 1, sq0 = (C.tid & 1) * 8;
        const float* ubase = U32 + ((size_t)g * T + (size_t)b * SEQ + sr) * 16 + sq0;
        f32x4 un0 = *(const f32x4*)ubase, un1 = *(const f32x4*)(ubase + 4);
        f32x4 um0 = *(const f32x4*)(ubase + 256 * 16), um1 = *(const f32x4*)(ubase + 256 * 16 + 4);
        float cr = 0.f, ci = 0.f;
        const f32x4 dvq = *(const f32x4*)(dskip + g * 16 + 4 * (C.lane >> 4));
        LAS v4u* myre = (LAS v4u*)(BuT + n * 264 + C.wave * 32); LAS v4u* myim = (LAS v4u*)(BuT + (64 + n) * 264 + C.wave * 32);
        for (int it = 0; it < 16; ++it) {
            const int tb = it * 256;
            *(LAS f32x4*)(uL + sr * 16 + sq0) = un0; *(LAS f32x4*)(uL + sr * 16 + sq0 + 4) = un1;
            { v4u w; w.x = pk2(un0.x, un0.y); w.y = pk2(un0.z, un0.w); w.z = pk2(un1.x, un1.y); w.w = pk2(un1.z, un1.w); *(LAS v4u*)(Ub + sr * 40 + sq0) = w; }
            un0 = um0; un1 = um1;
            if (it + 2 < 16) { const float* src = ubase + (size_t)(tb + 512) * 16; um0 = *(const f32x4*)src; um1 = *(const f32x4*)(src + 4); }
            __syncthreads();
            lds_mmx<256, 128, 32, false, false, 0, 4>(Ub, 40, BBm, 40, Ub, 40, BBm, 40, C.wave, C.lane, [=](int tok0, int st, f32x4 v) { *(LAS v2u*)(BuT + st * 264 + tok0) = pack4(v); });
            __syncthreads();
            v4u br[4], bi[4];
#pragma unroll
            for (int k = 0; k < 4; ++k) { br[k] = myre[k]; bi[k] = myim[k]; }
            float xr = 0.f, xi = 0.f;
#pragma unroll
            for (int k = 0; k < 4; ++k)
#pragma unroll
                for (int e = 0; e < 4; ++e) { const unsigned wr_ = br[k][e], wi_ = bi[k][e];
                    float nxr = ar * xr - ai * xi + bflo(wr_), nxi = ar * xi + ai * xr + bflo(wi_); xr = nxr; xi = nxi;
                    nxr = ar * xr - ai * xi + bfhi(wr_); nxi = ar * xi + ai * xr + bfhi(wi_); xr = nxr; xi = nxi; }
            xend[(C.wave * 64 + n) * 2] = xr; xend[(C.wave * 64 + n) * 2 + 1] = xi;
            __syncthreads();
            float Xr = cr, Xi = ci, myr = 0.f, myi = 0.f;
#pragma unroll
            for (int w = 0; w < 8; ++w) { if (w == C.wave) { myr = Xr; myi = Xi; }
                const float er = xend[(w * 64 + n) * 2], ei = xend[(w * 64 + n) * 2 + 1];
                const float nXr = a32r * Xr - a32i * Xi + er, nXi = a32r * Xi + a32i * Xr + ei; Xr = nXr; Xi = nXi; }
            cr = Xr; ci = Xi;
            xr = myr; xi = myi;
#pragma unroll
            for (int k = 0; k < 4; ++k) {
#pragma unroll
                for (int e = 0; e < 4; ++e) { const unsigned wr_ = br[k][e], wi_ = bi[k][e];
                    float nxr = ar * xr - ai * xi + bflo(wr_), nxi = ar * xi + ai * xr + bflo(wi_); xr = nxr; xi = nxi; const float r0 = xr, i0 = xi;
                    nxr = ar * xr - ai * xi + bfhi(wr_); nxi = ar * xi + ai * xr + bfhi(wi_); xr = nxr; xi = nxi;
                    br[k][e] = pk2(r0, xr); bi[k][e] = pk2(i0, xi); }
                myre[k] = br[k]; myim[k] = bi[k]; }
            __syncthreads();
            const int trow0 = b * SEQ + tb;
            lds_mmx<16, 256, 128, false, true, 0, 2>(Cm, 136, BuT, 264, Cm, 136, BuT, 264, C.wave, C.lane, [=](int p0, int tok, f32x4 v) {
                const f32x4 dv = dvq; const f32x4 uv = *(const LAS f32x4*)(uL + tok * 16 + p0);
                const f32x4 y = v + dv * uv;
#if S5_FP8
                *(unsigned*)((unsigned char*)YG + ((size_t)g * T + trow0 + tok) * 16 + p0) = pg8::cvt4_fp8(gelu_tanh(y.x), gelu_tanh(y.y), gelu_tanh(y.z), gelu_tanh(y.w));
#else
                v2u w; w.x = pk2(gelu_tanh(y.x), gelu_tanh(y.y)); w.y = pk2(gelu_tanh(y.z), gelu_tanh(y.w));
                *(v2u*)(YG + (size_t)(trow0 + tok) * D + g * 16 + p0) = w;
#endif
                });
            __syncthreads();
        }
    }
}

__device__ __forceinline__ void moe_r1(const Ctx& C, const bf16* X, const float* gain, const float* router, const float* rb, bf16* XN, int* TE, float* TW, int* CNT) {
    LAS int* cnt = (LAS int*)(C.lds + 32768);
    f32x4 wg[32];
#pragma unroll
    for (int j = 0; j < 4; ++j)
#pragma unroll
        for (int cc = 0; cc < 4; ++cc) { const float* wp = router + (size_t)(256 * j + 4 * C.lane + cc) * 8; wg[(4 * j + cc) * 2] = *(const f32x4*)wp; wg[(4 * j + cc) * 2 + 1] = *(const f32x4*)(wp + 4); }
    float rbv[8];
#pragma unroll
    for (int e = 0; e < 8; ++e) rbv[e] = rb[e];
    if (C.tid < 8) cnt[C.tid] = 0;
    __syncthreads();
    f32x4 g[4];
#pragma unroll
    for (int j = 0; j < 4; ++j) g[j] = ((const f32x4*)gain)[C.lane + 64 * j];
    constexpr int R1PD = 4;
#pragma unroll 1
    for (int i0 = 0; i0 < 8; i0 += R1PD) {
      v2u rb[R1PD][4];
#pragma unroll
      for (int r = 0; r < R1PD; ++r)
#pragma unroll
        for (int j = 0; j < 4; ++j) rb[r][j] = ((const v2u*)(X + (size_t)(C.blk * 64 + C.wave * 8 + i0 + r) * D))[C.lane + 64 * j];
#pragma unroll
      for (int r = 0; r < R1PD; ++r) {
        const int m = C.blk * 64 + C.wave * 8 + i0 + r;
        f32x4 v[4]; float ss = 0.f;
#pragma unroll
        for (int j = 0; j < 4; ++j) v[j] = (f32x4){bflo(rb[r][j].x), bfhi(rb[r][j].x), bflo(rb[r][j].y), bfhi(rb[r][j].y)};
#pragma unroll
        for (int j = 0; j < 4; ++j) ss += (v[j].x * v[j].x + v[j].y * v[j].y) + (v[j].z * v[j].z + v[j].w * v[j].w);
        const float inv = rsqrtf(wave_sum(ss) * (1.f / D) + EPS);
        unsigned* o4 = (unsigned*)((unsigned char*)XN + (size_t)m * D) + C.lane;
#pragma unroll
        for (int j = 0; j < 4; ++j) { v[j] = v[j] * inv * g[j]; o4[64 * j] = pg8::cvt4_fp8(v[j].x, v[j].y, v[j].z, v[j].w); }
        float p[8];
#pragma unroll
        for (int e = 0; e < 8; ++e) p[e] = 0.f;
#pragma unroll
        for (int j = 0; j < 4; ++j)
#pragma unroll
            for (int c = 0; c < 4; ++c) { const f32x4 w0 = wg[(4 * j + c) * 2], w1 = wg[(4 * j + c) * 2 + 1]; const float h = v[j][c];
                p[0] += h * w0.x; p[1] += h * w0.y; p[2] += h * w0.z; p[3] += h * w0.w; p[4] += h * w1.x; p[5] += h * w1.y; p[6] += h * w1.z; p[7] += h * w1.w; }
        { const float tot = wave_sum8(p, C.lane);
#pragma unroll
          for (int e = 0; e < 8; ++e) p[e] = __shfl(tot, (e >> 2) | (((e >> 1) & 1) << 1) | ((e & 1) << 2)) + rbv[e]; }
        int e1 = 0; float v1 = p[0];
#pragma unroll
        for (int e = 1; e < 8; ++e) if (p[e] > v1) { v1 = p[e]; e1 = e; }
        int e2 = -1; float v2 = -3.0e38f;
#pragma unroll
        for (int e = 0; e < 8; ++e) if (e != e1 && p[e] > v2) { v2 = p[e]; e2 = e; }
        const float w1 = 1.0f / (1.0f + __expf(v2 - v1)), w2 = 1.0f - w1;
        if (C.lane == 0) { TE[m] = e1 | (e2 << 8); TW[2 * m] = w1; TW[2 * m + 1] = w2; atomicAdd((int*)&cnt[e1], 1); atomicAdd((int*)&cnt[e2], 1); }
      }
    }
    __syncthreads();
    if (C.tid < 8) CNT[C.blk * 8 + C.tid] = cnt[C.tid];
    __syncthreads();
}
__device__ __forceinline__ void moe_r2(const Ctx& C, const bf16* XN, const int* TE, const float* TW, const int* CNT, int* SLOT, float* GW, int* PANEL_E, unsigned char* XG8) {
    LAS int* tot = (LAS int*)(C.lds); LAS int* pre = tot + 8; LAS int* base = tot + 16; LAS int* slotL = tot + 32;
    if (C.tid < 16) tot[C.tid] = 0;
    __syncthreads();
    for (int q = C.tid; q < C.G * 2; q += NTHR) { const int bb = q >> 1, e0 = (q & 1) * 4; const v4u c = *(const v4u*)(CNT + bb * 8 + e0);
        atomicAdd((int*)&tot[e0], (int)c.x); atomicAdd((int*)&tot[e0 + 1], (int)c.y); atomicAdd((int*)&tot[e0 + 2], (int)c.z); atomicAdd((int*)&tot[e0 + 3], (int)c.w);
        if (bb < C.blk) { atomicAdd((int*)&pre[e0], (int)c.x); atomicAdd((int*)&pre[e0 + 1], (int)c.y); atomicAdd((int*)&pre[e0 + 2], (int)c.z); atomicAdd((int*)&pre[e0 + 3], (int)c.w); } }
    __syncthreads();
    if (C.tid == 0) { int acc = 0; for (int e = 0; e < 8; ++e) { base[e] = acc; acc += (tot[e] + 255) & ~255; } base[8] = acc;
        if (C.blk == 0) { for (int e = 0; e < 8; ++e) for (int p = base[e] >> 8; p < (base[e + 1] >> 8); ++p) PANEL_E[p] = e; PANEL_E[MAXPANEL] = acc >> 8; } }
    __syncthreads();
    if (C.wave == 0) {
        const int t = C.blk * 64 + C.lane; const int te = TE[t]; const int e1 = te & 255, e2 = te >> 8; int s1 = 0, s2 = 0;
        const unsigned long long below = (C.lane == 0) ? 0ull : (~0ull >> (64 - C.lane));
#pragma unroll
        for (int e = 0; e < 8; ++e) { const unsigned long long mem = __ballot(e1 == e || e2 == e); const int pos = base[e] + pre[e] + __popcll(mem & below);
            if (e1 == e) s1 = pos; if (e2 == e) s2 = pos; }
        SLOT[2 * t] = s1; SLOT[2 * t + 1] = s2; GW[s1] = TW[2 * t]; GW[s2] = TW[2 * t + 1]; slotL[2 * C.lane] = s1; slotL[2 * C.lane + 1] = s2;
    }
    __syncthreads();
    for (int r0 = C.wave * 16; r0 < C.wave * 16 + 16; r0 += 8) { v4u a[4];
#pragma unroll
        for (int k = 0; k < 4; ++k) { const int t = C.blk * 64 + ((r0 + 2 * k) >> 1); a[k] = ((const v4u*)((const unsigned char*)XN + (size_t)t * D))[C.lane]; }
#pragma unroll
        for (int k = 0; k < 4; ++k) { *((v4u*)(XG8 + (size_t)slotL[r0 + 2 * k] * D) + C.lane) = a[k]; *((v4u*)(XG8 + (size_t)slotL[r0 + 2 * k + 1] * D) + C.lane) = a[k]; } }
    const int gw = C.blk * NWAVES + C.wave, NGW = C.G * NWAVES;
    for (int e = 0; e < 8; ++e) { const int t = tot[e]; const int npad = ((t + 255) & ~255) - t;
        for (int k = gw; k < npad; k += NGW) { const int row = base[e] + t + k; v4u* d = (v4u*)(XG8 + (size_t)row * D); const v4u z = {0u, 0u, 0u, 0u}; d[C.lane] = z; if (C.lane == 0) GW[row] = 0.f; } }
    __syncthreads();
}
template <bool FINAL, bool XN8 = false>
__device__ __forceinline__ void combine_phase(const Ctx& C, bf16* X, const bf16* Y, const int* SLOT, const float* gain, bf16* XN, float* out) {
    const int gw = C.blk * NWAVES + C.wave, NGW = C.G * NWAVES;
    f32x4 g[4];
#pragma unroll
    for (int j = 0; j < 4; ++j) g[j] = ((const f32x4*)gain)[C.lane + 64 * j];
    constexpr int CPD = 4;
    for (int m0 = gw; m0 < T; m0 += NGW * CPD) {
      int s1[CPD], s2[CPD];
#pragma unroll
      for (int r = 0; r < CPD; ++r) { const int mr = m0 + r * NGW; s1[r] = 0; s2[r] = 0; if (mr < T) { s1[r] = SLOT[2 * mr]; s2[r] = SLOT[2 * mr + 1]; } }
      v2u xr[CPD][4], ya[CPD][4], yb[CPD][4];
#pragma unroll
      for (int r = 0; r < CPD; ++r) { const int mr = m0 + r * NGW;
        if (mr < T) { const v2u* y1 = (const v2u*)(Y + (size_t)s1[r] * D) + C.lane; const v2u* y2 = (const v2u*)(Y + (size_t)s2[r] * D) + C.lane; const v2u* xp = (const v2u*)(X + (size_t)mr * D) + C.lane;
#pragma unroll
            for (int j = 0; j < 4; ++j) { xr[r][j] = xp[64 * j]; ya[r][j] = y1[64 * j]; yb[r][j] = y2[64 * j]; } } }
#pragma unroll
      for (int r = 0; r < CPD; ++r) { const int m = m0 + r * NGW;
       if (m < T) {
        f32x4 v[4]; v2u a[4], b[4]; float ss = 0.f;
#pragma unroll
        for (int j = 0; j < 4; ++j) { v[j] = (f32x4){bflo(xr[r][j].x), bfhi(xr[r][j].x), bflo(xr[r][j].y), bfhi(xr[r][j].y)}; a[j] = ya[r][j]; b[j] = yb[r][j]; }
#pragma unroll
        for (int j = 0; j < 4; ++j) {
            v[j].x += bflo(a[j].x) + bflo(b[j].x); v[j].y += bfhi(a[j].x) + bfhi(b[j].x); v[j].z += bflo(a[j].y) + bflo(b[j].y); v[j].w += bfhi(a[j].y) + bfhi(b[j].y);
            ss += (v[j].x * v[j].x + v[j].y * v[j].y) + (v[j].z * v[j].z + v[j].w * v[j].w); }
        const float inv = rsqrtf(wave_sum(ss) * (1.f / D) + EPS);
        if constexpr (FINAL) { f32x4* o = (f32x4*)(out + (size_t)m * D) + C.lane;
#pragma unroll
            for (int j = 0; j < 4; ++j) o[64 * j] = v[j] * inv * g[j];
        } else { v2u* xw = (v2u*)(X + (size_t)m * D) + C.lane; unsigned long long* o8 = (unsigned long long*)(XN + (size_t)m * D) + C.lane;
#pragma unroll
            for (int j = 0; j < 4; ++j) { v2u xo; xo.x = pk2(v[j].x, v[j].y); xo.y = pk2(v[j].z, v[j].w); xw[64 * j] = xo; const f32x4 hn = v[j] * inv * g[j];
                if constexpr (XN8) ((unsigned*)((unsigned char*)XN + (size_t)m * D) + C.lane)[64 * j] = pg8::cvt4_fp8(hn.x, hn.y, hn.z, hn.w);
                else o8[64 * j] = (unsigned long long)pk2(hn.x, hn.y) | ((unsigned long long)pk2(hn.z, hn.w) << 32); } }
       } }
    }
}

struct Args { const float* in[30]; float* out; unsigned char* ws; int ph_lo, ph_hi, li, pad; };
constexpr int NPHASES = 35;

__global__ void __launch_bounds__(NTHR, 2) fwd_kernel(Args args) {
    extern __shared__ __attribute__((aligned(16))) unsigned char lds_raw[];
    Ctx C; C.lds = (LAS unsigned char*)lds_raw; C.wave = __builtin_amdgcn_readfirstlane(threadIdx.x >> 6); C.lane = pg8::lane_asm(); C.tid = C.wave * 64 + C.lane; C.blk = blockIdx.x; C.G = gridDim.x;
#define REFRESH() do { C.lane = pg8::lane_asm(); C.tid = C.wave * 64 + C.lane; } while (0)
    volatile LAS unsigned* MISC = (volatile LAS unsigned*)(C.lds + MISC_OFF);
    unsigned char* ws = args.ws;
    unsigned* ctl = (unsigned*)(ws + WS_CTL);
    for (int u = C.tid; u < (LDS_BYTES - RING_BYTES) / 4; u += NTHR) ((LAS unsigned*)(C.lds + RING_BYTES))[u] = 0u;
    __syncthreads();
#if MK_PER_PHASE
#define GRID_BAR() do { } while (0)
#else
    XcdBarrier bar = xcd_barrier_post(ctl + CW_BAR, MISC + 8, C.wave);
#define GRID_BAR() xcd_barrier(bar)
#endif
    const int lo = args.ph_lo, hi = args.ph_hi;
#define IN_(k) (lo <= (k) && (k) < hi)
#define IN(k) (IN_(k) && (C.lane = pg8::lane_asm(), C.tid = C.wave * 64 + C.lane, true))
#define SEAM(k) do { if (IN_(k) && IN_((k) + 1)) { GRID_BAR(); } } while (0)
    const float* const* in = args.in;
    const float* x_in = in[0];
    bf16* X = (bf16*)(ws + WS_X); unsigned char* X8 = ws + WS_X8; float* SSQA = (float*)(ws + WS_SSQ); float* SSQB = (float*)(ws + WS_SSQ + 2 * MiB); float* SSQC = (float*)(ws + WS_SSQ + 4 * MiB); bf16* XN = (bf16*)(ws + WS_XN);
    bf16* PROJ = (bf16*)(ws + WS_PROJ); bf16* QKC = (bf16*)(ws + WS_QKC); bf16* UC = (bf16*)(ws + WS_UC); bf16* CS = (bf16*)(ws + WS_CS); bf16* Gb = (bf16*)(ws + WS_G);
    bf16* Hb = (bf16*)(ws + WS_H); unsigned char* H8 = ws + WS_H; unsigned char* XG8 = ws + WS_XG; bf16* Yb = (bf16*)(ws + WS_Y); float* U32 = (float*)(ws + WS_U32);
    LAS unsigned char* ring = C.lds;

#define GEMM_DENSE(EPI, Aptr, Bptr, NN, KK, EOBJ) do { pg8::Gemm g_{(const pg8::bf16_t*)(Aptr), (const pg8::bf16_t*)(Bptr), T, (NN), (KK), 0, C.wave}; pg8::StaticOrder S_; S_.init(T, (NN), C.G, C.blk); \
        pg8::gemm_phase<EPI, pg8::StaticOrder, true, true>(ring, g_, S_, EOBJ); } while (0)

#define ML_LAYER(P0, J, LAYER, XSRC, XBF_) do { \
    float* gates_ = (float*)(ws + TAB_GATES + (J) * 524288); float* BC_ = (float*)(ws + TAB_BC + (J) * 4096); float* PC_ = (float*)(ws + TAB_PC + (J) * 4096); float* MP_ = (float*)(ws + TAB_MPREV + (J) * 4096); \
    float* NU_ = (float*)(ws + TAB_NU + (J) * 524288); float* NS_ = (float*)(ws + TAB_NS + (J) * 524288); \
    if (IN((P0))) { norm_phase<true, (XBF_), XBF_>(C, (XSRC), in[1] + (LAYER) * D, XN, in[4] + (size_t)(J) * D * 3080, in[5] + (J) * 8, gates_); } SEAM((P0)); \
    if (IN((P0) + 1)) { if constexpr (XBF_) {   \
            pg8::Gemm g_{(const pg8::bf16_t*)XN, (const pg8::bf16_t*)(ws + W_ML_IN + (J) * SZ_ML_IN), T, 3072, D / 2, 0, C.wave}; pg8::StaticOrder S_; S_.init(T, 3072, C.G, C.blk); \
            pg8::EpiBf16<0> E_{(pg8::bf16_t*)PROJ, 3072, 3072, 0.015625f, nullptr}; pg8::gemm_phase<pg8::EpiBf16<0>, pg8::StaticOrder, true, true, true>(ring, g_, S_, E_); \
        } else { pg8::EpiBf16<0> E_{(pg8::bf16_t*)PROJ, 3072, 0, 1.f, nullptr}; GEMM_DENSE(pg8::EpiBf16<0>, XN, ws + W_ML_IN + (J) * SZ_ML_IN, 3072, D, E_); } } SEAM((P0) + 1); \
    bf16* GT_ = CS; bf16* GS_ = CS + (size_t)8 * MiB; float* NT_ = NS_; float* NSg_ = NS_ + 65536;     \
    if (IN((P0) + 2)) { ml_m1(C, PROJ, gates_, in[6] + (J) * 4096, QKC, UC, GT_, NU_, NT_, MP_, BC_, PC_); } SEAM((P0) + 2); \
    if (IN((P0) + 3)) { ml_m2(C, GT_, GS_, NT_, NSg_, PC_); } SEAM((P0) + 3); \
    if (IN((P0) + 4)) { ml_m3<(XBF_)>(C, QKC, PROJ, UC, GS_, NU_, NSg_, MP_, BC_, gates_, in[7] + (J) * D, Gb); } SEAM((P0) + 4); \
    if (IN((P0) + 5)) { using ER_ = pg8::EpiRes<!(XBF_), !(XBF_)>; \
        if constexpr (XBF_) { pg8::Gemm g_{(const pg8::bf16_t*)Gb, (const pg8::bf16_t*)(ws + W_ML_OUT + (J) * SZ_ML_OUT), T, D, D / 2, 0, C.wave}; pg8::StaticOrder S_; S_.init(T, D, C.G, C.blk); \
            ER_ E_{(XSRC), (pg8::bf16_t*)X, D, 0.015625f, SSQA}; pg8::gemm_phase<ER_, pg8::StaticOrder, true, true, true>(ring, g_, S_, E_); } \
        else { ER_ E_{(XSRC), (pg8::bf16_t*)X, D, 1.f, SSQA}; GEMM_DENSE(ER_, Gb, ws + W_ML_OUT + (J) * SZ_ML_OUT, D, D, E_); } } SEAM((P0) + 5); \
  } while (0)
#define DENSE_FFN(P0, F, LAYER) do { \
      \
    if (IN((P0) + 1)) { pg8::EpiSwiGLU<16> E_{(pg8::bf16_t*)Hb, FFD, SSQA}; GEMM_DENSE(pg8::EpiSwiGLU<16>, X, ws + W_FF_GU + (F) * SZ_FF_GU, 2 * FFD, D, E_); \
        if ((F) == 0 && C.blk >= 128) { REFRESH(); convert_phase(C, in, ws, 1, (C.blk - 128) * NWAVES + C.wave, 128 * NWAVES); } } SEAM((P0) + 1); \
    if (IN((P0) + 2)) { using ER_ = pg8::EpiRes<false, true, (AT_FP8 != 0)>; ER_ E_{X, (pg8::bf16_t*)X, D, 1.f, SSQB, X8}; GEMM_DENSE(ER_, Hb, ws + W_FF_D + (F) * SZ_FF_D, D, FFD, E_); } SEAM((P0) + 2); \
  } while (0)
#define DENSE_FFN8(P0, F, LAYER) do { \
      \
    if (IN((P0) + 1)) { pg8::Gemm g_{(const pg8::bf16_t*)X8, (const pg8::bf16_t*)(ws + W_FF_GU + (F) * SZ_FF_GU), T, 2 * FFD, D / 2, 0, C.wave}; pg8::StaticOrder S_; S_.init(T, 2 * FFD, C.G, C.blk); \
        pg8::EpiSwiGLU8<32> E_{H8, FFD, 0.015625f, 8.f, SSQC}; pg8::gemm_phase<pg8::EpiSwiGLU8<32>, pg8::StaticOrder, true, true, true>(ring, g_, S_, E_); \
        if (C.blk >= 128) { REFRESH(); convert_phase(C, in, ws, 3, (C.blk - 128) * NWAVES + C.wave, 128 * NWAVES); } } SEAM((P0) + 1); \
    if (IN((P0) + 2)) { pg8::Gemm g_{(const pg8::bf16_t*)H8, (const pg8::bf16_t*)(ws + W_FF_D + (F) * SZ_FF_D), T, D, FFD / 2, 0, C.wave}; pg8::StaticOrder S_; S_.init(T, D, C.G, C.blk); \
        pg8::EpiRes<false> E_{X, (pg8::bf16_t*)X, D, 0.001953125f, nullptr}; pg8::gemm_phase<pg8::EpiRes<false>, pg8::StaticOrder, true, true, true>(ring, g_, S_, E_); } SEAM((P0) + 2); \
  } while (0)
#define MOE_FFN(P0, F, LAYER, FINAL, NEXTGAIN) do { \
    unsigned char* mt_ = ws + TAB_MOE + (F) * MiB; int* TE_ = (int*)(mt_ + MOE_TE); float* TW_ = (float*)(mt_ + MOE_TW); int* SLOT_ = (int*)(mt_ + MOE_SLOT); float* GW_ = (float*)(mt_ + MOE_GW); \
    int* CNT_ = (int*)(mt_ + MOE_CNT); int* PE_ = (int*)(mt_ + MOE_PANEL); \
    if (IN((P0))) { moe_r1(C, X, in[2] + (LAYER) * D, in[25] + (F) * 8192, in[26] + (F) * 8, XN, TE_, TW_, CNT_); } SEAM((P0)); \
    if (IN((P0) + 1)) { moe_r2(C, XN, TE_, TW_, CNT_, SLOT_, GW_, PE_, XG8); } SEAM((P0) + 1); \
    if (IN((P0) + 2)) { const int np_ = __builtin_amdgcn_readfirstlane(__hip_atomic_load(PE_ + MAXPANEL, __ATOMIC_RELAXED, __HIP_MEMORY_SCOPE_AGENT)); \
        LAS int* peL_ = (LAS int*)(C.lds + RING_BYTES + 8192); if (C.tid < MAXPANEL) peL_[C.tid] = __hip_atomic_load(PE_ + C.tid, __ATOMIC_RELAXED, __HIP_MEMORY_SCOPE_AGENT); __syncthreads(); \
        pg8::Gemm g_{(const pg8::bf16_t*)XG8, (const pg8::bf16_t*)(ws + W_MOE_GU + (size_t)(F) * 8 * SZ_MOE_GU), MAXSLOT, 2 * FFE, D / 2, SZ_MOE_GU, C.wave}; pg8::MoeOrder S_{peL_, np_, 2 * FFE / 256, C.G, C.blk}; \
        pg8::EpiSwiGLU8<0> E_{H8, FFE, 0.015625f, 8.f, nullptr}; pg8::gemm_phase<pg8::EpiSwiGLU8<0>, pg8::MoeOrder, true, true, true>(ring, g_, S_, E_); \
        if constexpr (PROBE == 1 && (F) == 1) { GRID_BAR(); pg8::gemm_phase<pg8::EpiSwiGLU8<0>, pg8::MoeOrder, true, true, true>(ring, g_, S_, E_); } } SEAM((P0) + 2); \
    if (IN((P0) + 3)) { const int np_ = __builtin_amdgcn_readfirstlane(__hip_atomic_load(PE_ + MAXPANEL, __ATOMIC_RELAXED, __HIP_MEMORY_SCOPE_AGENT)); \
        LAS int* peL_ = (LAS int*)(C.lds + RING_BYTES + 8192); if (C.tid < MAXPANEL) peL_[C.tid] = __hip_atomic_load(PE_ + C.tid, __ATOMIC_RELAXED, __HIP_MEMORY_SCOPE_AGENT); __syncthreads(); \
        pg8::Gemm g_{(const pg8::bf16_t*)H8, (const pg8::bf16_t*)(ws + W_MOE_D + (size_t)(F) * 8 * SZ_MOE_D), MAXSLOT, D, FFE / 2, SZ_MOE_D, C.wave}; pg8::MoeOrder S_{peL_, np_, D / 256, C.G, C.blk}; \
        pg8::EpiRowScaleBf16 E_{(pg8::bf16_t*)Yb, D, GW_, 0.001953125f}; pg8::gemm_phase<pg8::EpiRowScaleBf16, pg8::MoeOrder, true, true, true>(ring, g_, S_, E_); \
        if constexpr (PROBE == 2 && (F) == 1) { GRID_BAR(); pg8::gemm_phase<pg8::EpiRowScaleBf16, pg8::MoeOrder, true, true, true>(ring, g_, S_, E_); } \
        if ((F) == 0 && (C.blk & 7) != 0) { REFRESH(); convert_phase(C, in, ws, 2, ((C.blk >> 3) * 7 + (C.blk & 7) - 1) * NWAVES + C.wave, 224 * NWAVES); } } SEAM((P0) + 3); \
    if (IN((P0) + 4)) { combine_phase<FINAL, (S5_FP8 != 0)>(C, X, Yb, SLOT_, (NEXTGAIN), XN, args.out); } SEAM((P0) + 4); \
  } while (0)

    if (IN(0)) { convert_phase(C, in, ws, 0, C.blk * NWAVES + C.wave, C.G * NWAVES); }
#if MK_PER_PHASE
    SEAM(0);
#endif
    ML_LAYER(1, 0, 0, x_in, false);
    DENSE_FFN(7, 0, 0);
#if AT_FP8
    if (IN(11)) { pg8::Gemm g_{(const pg8::bf16_t*)X8, (const pg8::bf16_t*)(ws + W_AT_IN), T, 3072, D / 2, 0, C.wave}; pg8::StaticOrder S_; S_.init(T, 3072, C.G, C.blk);
        pg8::EpiBf16<16> E_{(pg8::bf16_t*)PROJ, 3072, 1024, 0.18033688011112042f * 0.015625f, SSQB, 0.015625f}; pg8::gemm_phase<pg8::EpiBf16<16>, pg8::StaticOrder, true, true, true>(ring, g_, S_, E_); } SEAM(11);
    if (IN(12)) { attn_phase<true>(C, PROJ, in[10], Gb); } SEAM(12);
#else
    if (IN(11)) { pg8::EpiBf16<16> E_{(pg8::bf16_t*)PROJ, 3072, 1024, 0.18033688011112042f, SSQB}; GEMM_DENSE(pg8::EpiBf16<16>, X, ws + W_AT_IN, 3072, D, E_); } SEAM(11);
    if (IN(12)) { attn_phase<false>(C, PROJ, in[10], Gb); } SEAM(12);
#endif
#if AT_FP8
    if (IN(13)) { pg8::Gemm g_{(const pg8::bf16_t*)Gb, (const pg8::bf16_t*)(ws + W_AT_OUT), T, D, D / 2, 0, C.wave}; pg8::StaticOrder S_; S_.init(T, D, C.G, C.blk);
        pg8::EpiRes<false> E_{X, (pg8::bf16_t*)X, D, 0.015625f, nullptr}; pg8::gemm_phase<pg8::EpiRes<false>, pg8::StaticOrder, true, true, true>(ring, g_, S_, E_); } SEAM(13);
#else
    if (IN(13)) { pg8::EpiRes<false> E_{X, (pg8::bf16_t*)X, D, 1.f, nullptr}; GEMM_DENSE(pg8::EpiRes<false>, Gb, ws + W_AT_OUT, D, D, E_); } SEAM(13);
#endif
    MOE_FFN(14, 0, 1, false, in[1] + 2 * D);
#if S5_FP8
    if (IN(19)) { pg8::Gemm g_{(const pg8::bf16_t*)XN, (const pg8::bf16_t*)(ws + W_S5_IN), T, D, D / 2, 0, C.wave}; pg8::StaticOrder S_; S_.init(T, D, C.G, C.blk);
        pg8::EpiF32G E_{U32, T, 0.015625f}; pg8::gemm_phase<pg8::EpiF32G, pg8::StaticOrder, true, true, true>(ring, g_, S_, E_); } SEAM(19);
#else
    if (IN(19)) { pg8::EpiF32G E_{U32, T, 1.f}; GEMM_DENSE(pg8::EpiF32G, XN, ws + W_S5_IN, D, D, E_); } SEAM(19);
#endif
    if (IN(20)) { s5_phase(C, U32, in[13], in[14], in[15], in[16], in[17], in[18], in[19], in[20], Gb); } SEAM(20);
#if S5_FP8
    if (IN(21)) { pg8::Gemm g_{(const pg8::bf16_t*)Gb, (const pg8::bf16_t*)(ws + W_S5_OUT), T, 2 * D, D / 2, 0, C.wave, 16u, (unsigned)T * 16u}; pg8::StaticOrder S_; S_.init(T, 2 * D, C.G, C.blk);
        pg8::EpiGluRes E_{(const pg8::bf16_t*)X, (pg8::bf16_t*)X, D, X8, SSQC, 0.015625f}; pg8::gemm_phase<pg8::EpiGluRes, pg8::StaticOrder, true, true, true>(ring, g_, S_, E_); } SEAM(21);
#else
    if (IN(21)) { pg8::EpiGluRes E_{(const pg8::bf16_t*)X, (pg8::bf16_t*)X, D, X8, SSQC, 1.f}; GEMM_DENSE(pg8::EpiGluRes, Gb, ws + W_S5_OUT, 2 * D, D, E_); } SEAM(21);
#endif
    DENSE_FFN8(22, 1, 2);
    ML_LAYER(25, 1, 3, X, true);
    MOE_FFN(31, 1, 3, true, in[3]);
#undef IN
#undef IN_
#undef SEAM
}
constexpr int NPH = 36;

extern "C" void kernel_launch(void* const* d_in, const int* in_sizes, int n_in, void* d_out, int out_size, void* d_ws, size_t ws_size, hipStream_t stream) {
    static int grid = 0;
    if (grid == 0) {
        if (n_in != 30 || in_sizes[0] != T * D || out_size != T * D || ws_size < WS_END) { fprintf(stderr, "kernel_launch: unexpected problem (n_in %d, in0 %d, out %d, ws %zu < %zu); nothing launched\n", n_in, n_in > 0 ? in_sizes[0] : -1, out_size, ws_size, (size_t)WS_END); grid = -1; return; }
        int dev = 0, cus = 0, per_cu = 0;
        if (hipGetDevice(&dev) != hipSuccess || hipDeviceGetAttribute(&cus, hipDeviceAttributeMultiprocessorCount, dev) != hipSuccess) { fprintf(stderr, "kernel_launch: device query failed\n"); grid = -1; return; }
        if (hipFuncSetAttribute((const void*)fwd_kernel, hipFuncAttributeMaxDynamicSharedMemorySize, LDS_BYTES) != hipSuccess) { fprintf(stderr, "kernel_launch: hipFuncSetAttribute failed\n"); grid = -1; return; }
        if (hipOccupancyMaxActiveBlocksPerMultiprocessor(&per_cu, (const void*)fwd_kernel, NTHR, LDS_BYTES) != hipSuccess || per_cu < 1) fprintf(stderr, "kernel_launch: note: occupancy query reports %d workgroups per CU\n", per_cu);
        (void)hipGetLastError();
        if (cus != 256) { fprintf(stderr, "kernel_launch: built for 256 CUs, device has %d; nothing launched\n", cus); grid = -1; return; }
        grid = 256;
    }
    if (grid < 0) return;
    if (hipMemsetAsync((char*)d_ws + WS_CTL, 0, CTL_ZERO_BYTES, stream) != hipSuccess) { fprintf(stderr, "kernel_launch: memset failed\n"); return; }
    Args a{};
    for (int i = 0; i < 30; ++i) a.in[i] = (const float*)d_in[i];
    a.out = (float*)d_out; a.ws = (unsigned char*)d_ws; a.li = 0; a.pad = 0;
#if MK_PER_PHASE
    for (int p = 0; p < NPH; ++p) { a.ph_lo = p; a.ph_hi = p + 1; hipLaunchKernelGGL(fwd_kernel, dim3(grid), dim3(NTHR), LDS_BYTES, stream, a); }
#else
    a.ph_lo = 0; a.ph_hi = NPH;
    hipLaunchKernelGGL(fwd_kernel, dim3(grid), dim3(NTHR), LDS_BYTES, stream, a);
#endif
    const hipError_t le = hipPeekAtLastError();
    if (le != hipSuccess) fprintf(stderr, "kernel_launch: launch failed: %s\n", hipGetErrorName(le));
}
```

```cpp
#include <hip/hip_runtime.h>
#include <cstdio>
#include <cstdint>
namespace pg8 {
#define PG8_LAS __attribute__((address_space(3)))
typedef unsigned short bf16_t;
typedef short bf16x8 __attribute__((ext_vector_type(8)));
typedef float f32x4 __attribute__((ext_vector_type(4)));
typedef unsigned u32x4 __attribute__((ext_vector_type(4)));
constexpr int BM = 256, BK = 64, HALF = 128, HTB = HALF * BK * 2  , STAGE_BYTES = 8 * HTB, NXCD = 8, WGM = 4;

__host__ __device__ __forceinline__ int lds_byte(int r, int c) { const int st = (r >> 4) * 2 + (c >> 5), rr = r & 15, cc = c & 31, ob = rr * 64 + cc * 2; return st * 1024 + (ob ^ (((ob >> 9) & 1) << 5)); }
__host__ __device__ __forceinline__ void stage_rc(int b, int& R, int& C) { const int st = b / 1024, sb = b % 1024, swz = sb ^ (((sb >> 9) & 1) << 5); R = (st >> 1) * 16 + swz / 64; C = (st & 1) * 32 + (swz % 64) / 2; }
__host__ __device__ __forceinline__ int perm32(int rho) { const int n = rho >> 4, i = rho & 15; return 8 * (i >> 2) + 4 * n + (i & 3); }

struct Unit { int pm, pn, e; };
struct Gemm { const bf16_t* A; const bf16_t* Bt; int M, N, K; size_t bstride; int wave; unsigned a_rs = 0, a_ps = 0; };
__device__ __forceinline__ int lane_asm() { int l; asm volatile("v_mbcnt_lo_u32_b32 %0, -1, 0\n\tv_mbcnt_hi_u32_b32 %0, -1, %0" : "=v"(l)); return l; }


struct StaticOrder {
    int nM, nN, nwg, G, c;
    __host__ __device__ void init(int M, int N, int G_, int c_) { nM = M / BM; nN = N / BM; nwg = nM * nN; G = G_; c = c_; }
    __host__ __device__ bool next(int i, Unit& u) const {
        const long L = (long)i * G + c; if (L >= nwg) return false;
        int wgid = (int)L; { const int q = nwg / NXCD, r = nwg % NXCD, xcd = wgid % NXCD, off = wgid / NXCD; wgid = (xcd < r ? xcd * (q + 1) : r * (q + 1) + (xcd - r) * q) + off; }
        const int nig = WGM * nN, gid = wgid / nig, fm = gid * WGM, gsz = (nM - fm) < WGM ? (nM - fm) : WGM;
        u.pm = fm + ((wgid % nig) % gsz); u.pn = (wgid % nig) / gsz; u.e = 0; return true;
    }
    __device__ __forceinline__ void a_ready(const Unit&) const {}
    __device__ __forceinline__ void done(const Unit&) const {}
};
struct MoeOrder {
    const PG8_LAS int* panel_e; int npanels, nN, G, c;
    __device__ __forceinline__ bool next(int i, Unit& u) const {
        const int ngrp = nN >> 2, st = i * 8 + (c & 7), r = c >> 3;
        const int pg = (int)((unsigned)st / (unsigned)ngrp), ng = st - pg * ngrp;
        u.pm = pg * 8 + (r & 7); u.pn = ng * 4 + (r >> 3);
        if (u.pm >= npanels) return false;
        u.e = __builtin_amdgcn_readfirstlane(panel_e[u.pm]); return true;
    }
    __device__ __forceinline__ void a_ready(const Unit&) const {}
    __device__ __forceinline__ void done(const Unit&) const {}
};

__device__ __forceinline__ unsigned cvt_pk_bf16(float lo, float hi) { unsigned r; asm volatile("v_cvt_pk_bf16_f32 %0, %1, %2" : "=v"(r) : "v"(lo), "v"(hi)); return r; }

template <int NSLOT> __device__ __forceinline__ float row_inv(const float* ssqp, int row, int fq) {
    const float* p = ssqp + (size_t)row * NSLOT + (NSLOT / 4) * fq; float s;
    if constexpr (NSLOT == 16) { const f32x4 a = *(const f32x4*)p; s = (a.x + a.y) + (a.z + a.w); }
    else { const f32x4 a = *(const f32x4*)p, b = *(const f32x4*)(p + 4); s = ((a.x + a.y) + (a.z + a.w)) + ((b.x + b.y) + (b.z + b.w)); }
    s += __shfl_xor(s, 16); s += __shfl_xor(s, 32);
    return rsqrtf(s * (1.f / 1024.f) + 1e-6f);
}
template <int NSLOT> __device__ __forceinline__ void row_inv8(const float* ssqp, int row0, int fq, float (&inv)[2][4]) {
    float s[2][4];
#pragma unroll
    for (int ai = 0; ai < 2; ++ai)
#pragma unroll
        for (int m = 0; m < 4; ++m) { const float* p = ssqp + (size_t)(row0 + ai * HALF + m * 16) * NSLOT + (NSLOT / 4) * fq;
            if constexpr (NSLOT == 16) { const f32x4 a = *(const f32x4*)p; s[ai][m] = (a.x + a.y) + (a.z + a.w); }
            else { const f32x4 a = *(const f32x4*)p, b = *(const f32x4*)(p + 4); s[ai][m] = ((a.x + a.y) + (a.z + a.w)) + ((b.x + b.y) + (b.z + b.w)); } }
#pragma unroll
    for (int ai = 0; ai < 2; ++ai)
#pragma unroll
        for (int m = 0; m < 4; ++m) { float t = s[ai][m]; t += __shfl_xor(t, 16); t += __shfl_xor(t, 32); inv[ai][m] = rsqrtf(t * (1.f / 1024.f) + 1e-6f); }
}
template <int ROWINV = 0>
struct EpiBf16 {
    static constexpr bool PERM = true, AFTER_DRAIN = false;
    static constexpr int NST = 16;
    bf16_t* O; int ldc; int scale_cols; float scale0; const float* ssqp; float scale1 = 1.f;
    __device__ __forceinline__ void operator()(const f32x4 (&acc)[2][2][4][2], const Unit& u, int wr, int wc, int fr, int fq) const {
        const int row0 = u.pm * BM + wr * 64 + fr; const int colt = u.pn * BM; const float sc0 = (colt < scale_cols) ? scale0 : scale1;
        const int col0 = colt + wc * 32 + 8 * fq;
        float rinv[2][4]; if constexpr (ROWINV > 0) row_inv8<ROWINV>(ssqp, row0, fq, rinv);
#pragma unroll
        for (int ai = 0; ai < 2; ++ai)
#pragma unroll
            for (int m = 0; m < 4; ++m) { bf16_t* rowp = O + (size_t)(row0 + ai * HALF + m * 16) * ldc + col0;
                float sc = sc0; if constexpr (ROWINV > 0) sc *= rinv[ai][m];
#pragma unroll
                for (int bj = 0; bj < 2; ++bj) { const f32x4 v0 = acc[ai][bj][m][0] * sc, v1 = acc[ai][bj][m][1] * sc;
                    u32x4 w; w.x = cvt_pk_bf16(v0[0], v0[1]); w.y = cvt_pk_bf16(v0[2], v0[3]); w.z = cvt_pk_bf16(v1[0], v1[1]); w.w = cvt_pk_bf16(v1[2], v1[3]);
                    *(u32x4*)(rowp + bj * HALF) = w; } }
    }
};
struct EpiF32G {
    static constexpr bool PERM = false, AFTER_DRAIN = false;
    static constexpr int NST = 32;
    float* C; int M; float s;
    __device__ __forceinline__ void operator()(const f32x4 (&acc)[2][2][4][2], const Unit& u, int wr, int wc, int fr, int fq) const {
        const int row0 = u.pm * BM + wr * 64 + fr, col0 = u.pn * BM + wc * 32 + 4 * fq;
#pragma unroll
        for (int ai = 0; ai < 2; ++ai)
#pragma unroll
            for (int m = 0; m < 4; ++m) { const int row = row0 + ai * HALF + m * 16;
#pragma unroll
                for (int bj = 0; bj < 2; ++bj)
#pragma unroll
                    for (int n = 0; n < 2; ++n) { const int col = col0 + bj * HALF + n * 16; *(f32x4*)(C + ((size_t)(col >> 4) * M + row) * 16 + (col & 15)) = acc[ai][bj][m][n] * s; } }
    }
};
__device__ __forceinline__ unsigned pk2v(float lo, float hi) { typedef __bf16 bf2_t __attribute__((ext_vector_type(2))); typedef float f2_t __attribute__((ext_vector_type(2))); const f2_t v = {lo, hi}; return __builtin_bit_cast(unsigned, __builtin_convertvector(v, bf2_t)); }
__device__ __forceinline__ float bflo_(unsigned w) { return __builtin_bit_cast(float, w << 16); }
__device__ __forceinline__ float bfhi_(unsigned w) { return __builtin_bit_cast(float, w & 0xffff0000u); }
__device__ __forceinline__ unsigned cvt4_fp8(float a, float b, float c, float d) { int r = __builtin_amdgcn_cvt_pk_fp8_f32(a, b, 0, false); r = __builtin_amdgcn_cvt_pk_fp8_f32(c, d, r, true); return (unsigned)r; }
template <bool BASE_F32, bool SSQ = false, bool OUT8 = false>
struct EpiRes {
    static constexpr bool PERM = true, AFTER_DRAIN = false;
    static constexpr int NST = 16;
    const void* base; bf16_t* out; int ldc; float s; float* ssqp; unsigned char* out8 = nullptr;
    __device__ __forceinline__ void operator()(const f32x4 (&acc)[2][2][4][2], const Unit& u, int wr, int wc, int fr, int fq) const {
        const int row0 = u.pm * BM + wr * 64 + fr, col0 = u.pn * BM + wc * 32 + 8 * fq;
#pragma unroll
        for (int ai = 0; ai < 2; ++ai)
#pragma unroll
            for (int m = 0; m < 4; ++m) { const size_t off = (size_t)(row0 + ai * HALF + m * 16) * ldc + col0; float ss = 0.f;
#pragma unroll
                for (int bj = 0; bj < 2; ++bj) { const size_t i = off + bj * HALF; f32x4 b0, b1;
                    if constexpr (BASE_F32) { b0 = *(const f32x4*)((const float*)base + i); b1 = *(const f32x4*)((const float*)base + i + 4); }
                    else { const u32x4 r = *(const u32x4*)((const bf16_t*)base + i); b0 = (f32x4){bflo_(r.x), bfhi_(r.x), bflo_(r.y), bfhi_(r.y)}; b1 = (f32x4){bflo_(r.z), bfhi_(r.z), bflo_(r.w), bfhi_(r.w)}; }
                    const f32x4 v0 = b0 + acc[ai][bj][m][0] * s, v1 = b1 + acc[ai][bj][m][1] * s;
                    if constexpr (SSQ) ss += ((v0[0] * v0[0] + v0[1] * v0[1]) + (v0[2] * v0[2] + v0[3] * v0[3])) + ((v1[0] * v1[0] + v1[1] * v1[1]) + (v1[2] * v1[2] + v1[3] * v1[3]));
                    u32x4 w; w.x = pk2v(v0[0], v0[1]); w.y = pk2v(v0[2], v0[3]); w.z = pk2v(v1[0], v1[1]); w.w = pk2v(v1[2], v1[3]);
                    *(u32x4*)(out + i) = w;
                    if constexpr (OUT8) { typedef unsigned u32x2 __attribute__((ext_vector_type(2))); u32x2 w8;
                        w8.x = cvt4_fp8(__builtin_amdgcn_fmed3f(v0[0], -448.f, 448.f), __builtin_amdgcn_fmed3f(v0[1], -448.f, 448.f), __builtin_amdgcn_fmed3f(v0[2], -448.f, 448.f), __builtin_amdgcn_fmed3f(v0[3], -448.f, 448.f));
                        w8.y = cvt4_fp8(__builtin_amdgcn_fmed3f(v1[0], -448.f, 448.f), __builtin_amdgcn_fmed3f(v1[1], -448.f, 448.f), __builtin_amdgcn_fmed3f(v1[2], -448.f, 448.f), __builtin_amdgcn_fmed3f(v1[3], -448.f, 448.f));
                        *(u32x2*)(out8 + i) = w8; } }
                if constexpr (SSQ) { ss += __shfl_xor(ss, 16); ss += __shfl_xor(ss, 32); if (fq == 0) ssqp[(size_t)(row0 + ai * HALF + m * 16) * 16 + u.pn * 4 + wc] = ss; }
                asm volatile("" ::: "memory"); }
    }
};
__device__ __forceinline__ float sigmoidf_(float v) { return __builtin_amdgcn_rcpf(1.0f + __builtin_amdgcn_exp2f(v * -1.4426950408889634f)); }
template <int ROWINV = 0>
struct EpiSwiGLU {
    static constexpr bool PERM = true, AFTER_DRAIN = false;
    static constexpr int NST = 8;
    bf16_t* H; int ldh; const float* ssqp;
    __device__ __forceinline__ void operator()(const f32x4 (&acc)[2][2][4][2], const Unit& u, int wr, int wc, int fr, int fq) const {
        const int row0 = u.pm * BM + wr * 64 + fr, col0 = u.pn * HALF + wc * 32 + 8 * fq;
        float rinv[2][4]; if constexpr (ROWINV > 0) row_inv8<ROWINV>(ssqp, row0, fq, rinv);
#pragma unroll
        for (int ai = 0; ai < 2; ++ai)
#pragma unroll
            for (int m = 0; m < 4; ++m) { bf16_t* rowp = H + (size_t)(row0 + ai * HALF + m * 16) * ldh + col0;
                f32x4 h0, h1; float inv = 1.f, inv2 = 1.f; if constexpr (ROWINV > 0) { inv = rinv[ai][m]; inv2 = inv * inv; }
#pragma unroll
                for (int j = 0; j < 4; ++j) { const float g0 = acc[ai][0][m][0][j], g1 = acc[ai][0][m][1][j];
                    if constexpr (ROWINV > 0) { h0[j] = (g0 * acc[ai][1][m][0][j]) * (inv2 * sigmoidf_(g0 * inv)); h1[j] = (g1 * acc[ai][1][m][1][j]) * (inv2 * sigmoidf_(g1 * inv)); }
                    else { h0[j] = g0 * sigmoidf_(g0) * acc[ai][1][m][0][j]; h1[j] = g1 * sigmoidf_(g1) * acc[ai][1][m][1][j]; } }
                u32x4 w; w.x = cvt_pk_bf16(h0[0], h0[1]); w.y = cvt_pk_bf16(h0[2], h0[3]); w.z = cvt_pk_bf16(h1[0], h1[1]); w.w = cvt_pk_bf16(h1[2], h1[3]);
                *(u32x4*)rowp = w; }
    }
};
struct EpiGluRes {
    static constexpr bool PERM = true, AFTER_DRAIN = false;
    static constexpr int NST = 16;
    const bf16_t* base; bf16_t* out; int ldc; unsigned char* out8; float* ssqp; float s;
    __device__ __forceinline__ void operator()(const f32x4 (&acc)[2][2][4][2], const Unit& u, int wr, int wc, int fr, int fq) const {
        typedef unsigned u32x2 __attribute__((ext_vector_type(2)));
        const int row0 = u.pm * BM + wr * 64 + fr, col0 = u.pn * HALF + wc * 32 + 8 * fq;
#pragma unroll
        for (int ai = 0; ai < 2; ++ai)
#pragma unroll
            for (int m = 0; m < 4; ++m) { const size_t i = (size_t)(row0 + ai * HALF + m * 16) * ldc + col0;
                const u32x4 r = *(const u32x4*)(base + i);
                f32x4 v0 = (f32x4){bflo_(r.x), bfhi_(r.x), bflo_(r.y), bfhi_(r.y)}, v1 = (f32x4){bflo_(r.z), bfhi_(r.z), bflo_(r.w), bfhi_(r.w)};
#pragma unroll
                for (int j = 0; j < 4; ++j) { v0[j] += (acc[ai][0][m][0][j] * s) * sigmoidf_(acc[ai][1][m][0][j] * s); v1[j] += (acc[ai][0][m][1][j] * s) * sigmoidf_(acc[ai][1][m][1][j] * s); }
                u32x4 w; w.x = pk2v(v0[0], v0[1]); w.y = pk2v(v0[2], v0[3]); w.z = pk2v(v1[0], v1[1]); w.w = pk2v(v1[2], v1[3]);
                *(u32x4*)(out + i) = w;
                float ss = ((v0[0] * v0[0] + v0[1] * v0[1]) + (v0[2] * v0[2] + v0[3] * v0[3])) + ((v1[0] * v1[0] + v1[1] * v1[1]) + (v1[2] * v1[2] + v1[3] * v1[3]));
#pragma unroll
                for (int j = 0; j < 4; ++j) { v0[j] = __builtin_amdgcn_fmed3f(v0[j], -448.f, 448.f); v1[j] = __builtin_amdgcn_fmed3f(v1[j], -448.f, 448.f); }
                u32x2 w8; w8.x = cvt4_fp8(v0[0], v0[1], v0[2], v0[3]); w8.y = cvt4_fp8(v1[0], v1[1], v1[2], v1[3]);
                *(u32x2*)(out8 + i) = w8;
                ss += __shfl_xor(ss, 16); ss += __shfl_xor(ss, 32); if (fq == 0) ssqp[(size_t)(row0 + ai * HALF + m * 16) * 32 + u.pn * 4 + wc] = ss;
                asm volatile("" ::: "memory"); }
    }
};
struct EpiRowScaleBf16 {
    static constexpr bool PERM = true, AFTER_DRAIN = false;
    static constexpr int NST = 16;
    bf16_t* Y; int ldc; const float* roww; float s;
    __device__ __forceinline__ void operator()(const f32x4 (&acc)[2][2][4][2], const Unit& u, int wr, int wc, int fr, int fq) const {
        const int row0 = u.pm * BM + wr * 64 + fr; const int col0 = u.pn * BM + wc * 32 + 8 * fq;
#pragma unroll
        for (int ai = 0; ai < 2; ++ai)
#pragma unroll
            for (int m = 0; m < 4; ++m) { const int row = row0 + ai * HALF + m * 16; const float sc = roww[row] * s; bf16_t* rowp = Y + (size_t)row * ldc + col0;
#pragma unroll
                for (int bj = 0; bj < 2; ++bj) { const f32x4 v0 = acc[ai][bj][m][0] * sc, v1 = acc[ai][bj][m][1] * sc;
                    u32x4 w; w.x = cvt_pk_bf16(v0[0], v0[1]); w.y = cvt_pk_bf16(v0[2], v0[3]); w.z = cvt_pk_bf16(v1[0], v1[1]); w.w = cvt_pk_bf16(v1[2], v1[3]);
                    *(u32x4*)(rowp + bj * HALF) = w; } }
    }
};
template <int ROWINV = 0>
struct EpiSwiGLU8 {
    static constexpr bool PERM = true, AFTER_DRAIN = false;
    static constexpr int NST = 8;
    unsigned char* H; int ldh; float sin, sout; const float* ssqp;
    __device__ __forceinline__ void operator()(const f32x4 (&acc)[2][2][4][2], const Unit& u, int wr, int wc, int fr, int fq) const {
        const int row0 = u.pm * BM + wr * 64 + fr, col0 = u.pn * HALF + wc * 32 + 8 * fq;
        typedef unsigned u32x2 __attribute__((ext_vector_type(2)));
        const float c1_ = -1.4426950408889634f * sin, c2_ = sin * sin * sout;
        float rinv[2][4]; if constexpr (ROWINV > 0) row_inv8<ROWINV>(ssqp, row0, fq, rinv);
#pragma unroll
        for (int ai = 0; ai < 2; ++ai)
#pragma unroll
            for (int m = 0; m < 4; ++m) { unsigned char* rowp = H + (size_t)(row0 + ai * HALF + m * 16) * ldh + col0;
                f32x4 h0, h1; float c1 = c1_, c2 = c2_; if constexpr (ROWINV > 0) { const float inv = rinv[ai][m]; c1 *= inv; c2 *= inv * inv; }
#pragma unroll
                for (int j = 0; j < 4; ++j) { const float g0 = acc[ai][0][m][0][j], g1 = acc[ai][0][m][1][j];
                    const float r0 = __builtin_amdgcn_rcpf(1.0f + __builtin_amdgcn_exp2f(g0 * c1)), r1 = __builtin_amdgcn_rcpf(1.0f + __builtin_amdgcn_exp2f(g1 * c1));
                    h0[j] = __builtin_amdgcn_fmed3f((g0 * acc[ai][1][m][0][j]) * (r0 * c2), -448.f, 448.f);
                    h1[j] = __builtin_amdgcn_fmed3f((g1 * acc[ai][1][m][1][j]) * (r1 * c2), -448.f, 448.f); }
                u32x2 w; w.x = cvt4_fp8(h0[0], h0[1], h0[2], h0[3]); w.y = cvt4_fp8(h1[0], h1[1], h1[2], h1[3]);
                *(u32x2*)rowp = w; asm volatile("" ::: "memory"); }
    }
};
typedef int v8i_t __attribute__((ext_vector_type(8)));
typedef int v4i_t __attribute__((ext_vector_type(4)));
template <int N> __device__ __forceinline__ void pg8_wait_v() { asm volatile("s_waitcnt vmcnt(%0)" :: "n"(N) : "memory"); }
template <class Epi, class Sched, bool ALIGN_EPI = false, bool SP2 = false, bool FP8 = false>
__device__ __forceinline__ void gemm_phase(PG8_LAS unsigned char* lds, const Gemm g, const Sched& S, const Epi& E) {
    const int lane = lane_asm(), wid = g.wave, tid = wid * 64 + lane, wr = wid >> 2, wc = wid & 3, fr = lane & 15, fq = lane >> 4;
    const int K = g.K, nt = K / BK;
    unsigned voffA[2], voffB[2];
#pragma unroll
    for (int i = 0; i < 2; ++i) { int R, C; stage_rc(tid * 16 + i * 8192, R, C); const int Rb = Epi::PERM ? ((R & ~31) + perm32(R & 31)) : R;
        voffB[i] = (unsigned)(Rb * K + C) * 2u; }
    const unsigned rsA_ = g.a_rs ? g.a_rs : (unsigned)K * 2u, psA_ = g.a_ps ? g.a_ps : 16u;
#pragma unroll
    for (int i = 0; i < 2; ++i) { int R, C; stage_rc(tid * 16 + i * 8192, R, C); voffA[i] = (unsigned)R * rsA_ + (unsigned)(C >> 3) * psA_; }
    const unsigned kstep = (unsigned)(BK * 2);
    const unsigned hstep = (unsigned)HALF * K * 2;
    const unsigned tstep = 2 * hstep; const unsigned bstr = (unsigned)g.bstride;
    const unsigned kstepA = 8u * psA_, hstepA = (unsigned)HALF * rsA_, tstepA = 2u * hstepA;
    const __amdgpu_buffer_rsrc_t rsA = __builtin_amdgcn_make_buffer_rsrc((void*)g.A, 0, 0x7fffffff, 0x00020000), rsB = __builtin_amdgcn_make_buffer_rsrc((void*)g.Bt, 0, 0x7fffffff, 0x00020000);
    const unsigned ldsw = (unsigned)wid * 1024u;
    const int aoff = lds_byte(wr * 64 + fr, fq * 8), boff = lds_byte(wc * 32 + fr, fq * 8);
#define PG8_SA(b, h) (((b) * 2 + (h)) * HTB)
#define PG8_SB(b, h) ((4 + (b) * 2 + (h)) * HTB)
#define PG8_STAGE_(rs, bufoff, goff, voff) do { _Pragma("unroll") for (int _i = 0; _i < 2; ++_i) \
        __builtin_amdgcn_raw_ptr_buffer_load_lds(rs, (PG8_LAS void*)(lds + (bufoff) + ldsw + _i * 8192), 16, (int)(voff)[_i], (int)(goff), 0, 0); } while (0)
#define PG8_STAGEA(bufoff, goff, voff) PG8_STAGE_(rsA, bufoff, goff, voff)
#define PG8_STAGEB(bufoff, goff, voff) PG8_STAGE_(rsB, bufoff, goff, voff)
#define PG8_LD8(p) __builtin_shufflevector(*(const PG8_LAS v4i_t*)(p), *(const PG8_LAS v4i_t*)((p) + 1024), 0, 1, 2, 3, 4, 5, 6, 7)
#define PG8_LDA(dst, b, h) do { if constexpr (FP8) { _Pragma("unroll") for (int m = 0; m < 4; ++m) dst##8[m] = PG8_LD8(lds + PG8_SA(b, h) + aoff + m * 2048); } else { \
        _Pragma("unroll") for (int m = 0; m < 4; ++m) _Pragma("unroll") for (int k = 0; k < 2; ++k) dst[m][k] = *(const PG8_LAS bf16x8*)(lds + PG8_SA(b, h) + aoff + m * 2048 + k * 1024); } } while (0)
#define PG8_LDB(dst, b, h) do { if constexpr (FP8) { _Pragma("unroll") for (int n = 0; n < 2; ++n) dst##8[n] = PG8_LD8(lds + PG8_SB(b, h) + boff + n * 2048); } else { \
        _Pragma("unroll") for (int n = 0; n < 2; ++n) _Pragma("unroll") for (int k = 0; k < 2; ++k) dst[n][k] = *(const PG8_LAS bf16x8*)(lds + PG8_SB(b, h) + boff + n * 2048 + k * 1024); } } while (0)
#define PG8_CAT(x) __builtin_shufflevector(__builtin_bit_cast(v4i_t, (x)[0]), __builtin_bit_cast(v4i_t, (x)[1]), 0, 1, 2, 3, 4, 5, 6, 7)
#define PG8_MMA(ai, bj, At, Bt) do { __builtin_amdgcn_s_setprio(1); if constexpr (FP8) { _Pragma("unroll") for (int m = 0; m < 4; ++m) _Pragma("unroll") for (int n = 0; n < 2; ++n) \
        acc[ai][bj][m][n] = __builtin_amdgcn_mfma_scale_f32_16x16x128_f8f6f4(Bt##8[n], At##8[m], acc[ai][bj][m][n], 0, 0, 0, sc8, 0, sc8); } \
      else { _Pragma("unroll") for (int m = 0; m < 4; ++m) _Pragma("unroll") for (int n = 0; n < 2; ++n) _Pragma("unroll") for (int k = 0; k < 2; ++k) \
        acc[ai][bj][m][n] = __builtin_amdgcn_mfma_f32_16x16x32_bf16(Bt[n][k], At[m][k], acc[ai][bj][m][n], 0, 0, 0); } __builtin_amdgcn_s_setprio(0); } while (0)
#define PG8_WAIT_V(n) asm volatile("s_waitcnt vmcnt(" #n ")" ::: "memory")
#define PG8_WAIT_L(n) asm volatile("s_waitcnt lgkmcnt(" #n ")" ::: "memory")
#define PG8_BAR __builtin_amdgcn_s_barrier()
#define PG8_SCHED __builtin_amdgcn_sched_barrier(0)
#define PG8_KITER_SP2(WV) do { \
            PG8_LDB(B0, 0, 0); PG8_LDB(B1, 0, 1); PG8_SCHED; PG8_LDA(At, 0, 0); PG8_STAGEA(PG8_SA(1, 1), a1 + hstepA, voffA); \
            pg8_wait_v<WV>(); PG8_WAIT_L(0); PG8_BAR; PG8_MMA(0, 0, At, B0); PG8_MMA(0, 1, At, B1); PG8_BAR; PG8_SCHED; \
            PG8_LDA(At, 0, 1); PG8_STAGEB(PG8_SB(0, 0), b2, voffB); PG8_STAGEB(PG8_SB(0, 1), b2 + hstep, voffB); PG8_STAGEA(PG8_SA(0, 0), a2, voffA); \
            pg8_wait_v<WV>(); PG8_WAIT_L(0); PG8_BAR; PG8_MMA(1, 0, At, B0); PG8_MMA(1, 1, At, B1); PG8_BAR; PG8_SCHED; \
            PG8_LDB(B0, 1, 0); PG8_LDB(B1, 1, 1); PG8_SCHED; PG8_LDA(At, 1, 0); PG8_STAGEA(PG8_SA(0, 1), a2 + hstepA, voffA); \
            PG8_WAIT_V(8); PG8_WAIT_L(0); PG8_BAR; PG8_MMA(0, 0, At, B0); PG8_MMA(0, 1, At, B1); PG8_BAR; PG8_SCHED; \
            PG8_LDA(At, 1, 1); PG8_STAGEB(PG8_SB(1, 0), b3, voffB); PG8_STAGEB(PG8_SB(1, 1), b3 + hstep, voffB); PG8_STAGEA(PG8_SA(1, 0), a3, voffA); \
            PG8_WAIT_V(8); PG8_WAIT_L(0); PG8_BAR; PG8_MMA(1, 0, At, B0); PG8_MMA(1, 1, At, B1); PG8_BAR; PG8_SCHED; \
        } while (0)
    Unit cur, nxt; int ui = 0;
    if (!S.next(0, cur)) return;
    f32x4 acc[2][2][4][2];
#pragma unroll
    for (int a = 0; a < 2; ++a)
#pragma unroll
        for (int b = 0; b < 2; ++b)
#pragma unroll
            for (int m = 0; m < 4; ++m)
#pragma unroll
                for (int n = 0; n < 2; ++n) acc[a][b][m][n] = (f32x4){0.f, 0.f, 0.f, 0.f};
    bf16x8 At[4][2], B0[2][2], B1[2][2]; v8i_t At8[4], B08[2], B18[2]; const int sc8 = __builtin_amdgcn_readfirstlane(0x7F7F7F7F);
    unsigned cA = (unsigned)cur.pm * tstepA, cB = (unsigned)cur.e * bstr + (unsigned)cur.pn * tstep;
    S.a_ready(cur);
    if constexpr (SP2) {
        PG8_STAGEB(PG8_SB(0, 0), cB, voffB); PG8_STAGEB(PG8_SB(0, 1), cB + hstep, voffB); PG8_STAGEA(PG8_SA(0, 0), cA, voffA); PG8_STAGEA(PG8_SA(0, 1), cA + hstepA, voffA);
        if (wr == 1) PG8_BAR;
        PG8_WAIT_V(2); PG8_BAR;
        PG8_STAGEB(PG8_SB(1, 0), cB + kstep, voffB); PG8_STAGEA(PG8_SA(1, 0), cA + kstepA, voffA); PG8_STAGEB(PG8_SB(1, 1), cB + hstep + kstep, voffB);
        PG8_WAIT_V(6); PG8_BAR;
#pragma unroll
        for (int i = 0; i < Epi::NST; ++i) __builtin_amdgcn_raw_ptr_buffer_load_lds(rsA, (PG8_LAS void*)(lds + STAGE_BYTES + 2048 + wid * 512), 4, 4 * i, 0, 0, 0);
    } else {
        PG8_STAGEB(PG8_SB(0, 0), cB, voffB); PG8_STAGEA(PG8_SA(0, 0), cA, voffA); PG8_STAGEB(PG8_SB(0, 1), cB + hstep, voffB); PG8_STAGEA(PG8_SA(0, 1), cA + hstepA, voffA);
        if (wr == 1) PG8_BAR;
        PG8_WAIT_V(4); PG8_BAR;
        PG8_STAGEB(PG8_SB(1, 0), cB + kstep, voffB); PG8_STAGEA(PG8_SA(1, 0), cA + kstepA, voffA); PG8_STAGEB(PG8_SB(1, 1), cB + hstep + kstep, voffB);
        PG8_WAIT_V(6); PG8_BAR;
    }
    for (;;) {
        const bool has_next = S.next(ui + 1, nxt);
        const unsigned nA = has_next ? (unsigned)nxt.pm * tstepA : cA, nB = has_next ? (unsigned)nxt.e * bstr + (unsigned)nxt.pn * tstep : cB;
        if constexpr (SP2) {
            int t = 0;
            { const bool last = false; const unsigned a1 = cA + kstepA, a2 = cA + 2u * kstepA, b2 = cB + 2u * kstep, a3 = a2 + kstepA, b3 = b2 + kstep; (void)last;
              PG8_KITER_SP2(8 + Epi::NST); }
#pragma unroll 1
            for (t = 2; t < nt; t += 2) {
                const bool last = (t == nt - 2);
                const unsigned a1 = cA + (unsigned)(t + 1) * kstepA;
                const unsigned a2 = last ? nA : cA + (unsigned)(t + 2) * kstepA, b2 = last ? nB : cB + (unsigned)(t + 2) * kstep;
                const unsigned a3 = a2 + kstepA, b3 = b2 + kstep;
                if (last && has_next) S.a_ready(nxt);
                PG8_KITER_SP2(8);
            }
        } else {
#pragma unroll 1
        for (int t = 0; t < nt; t += 2) {
            const bool last = (t == nt - 2);
            const unsigned a1 = cA + (unsigned)(t + 1) * kstepA;
            const unsigned a2 = last ? nA : cA + (unsigned)(t + 2) * kstepA, b2 = last ? nB : cB + (unsigned)(t + 2) * kstep;
            const unsigned a3 = a2 + kstepA, b3 = b2 + kstep;
            if (last && has_next) S.a_ready(nxt);
            {
            PG8_LDB(B0, 0, 0); PG8_SCHED; PG8_LDA(At, 0, 0); PG8_STAGEA(PG8_SA(1, 1), a1 + hstepA, voffA);
            PG8_WAIT_L(8); PG8_BAR; PG8_WAIT_L(0); PG8_MMA(0, 0, At, B0); PG8_BAR; PG8_SCHED;
            PG8_LDB(B1, 0, 1); PG8_STAGEB(PG8_SB(0, 0), b2, voffB);
            PG8_BAR; PG8_WAIT_L(0); PG8_MMA(0, 1, At, B1); PG8_BAR;
            PG8_LDA(At, 0, 1); PG8_STAGEA(PG8_SA(0, 0), a2, voffA);
            PG8_BAR; PG8_WAIT_L(0); PG8_MMA(1, 0, At, B0); PG8_BAR; PG8_SCHED;
            PG8_STAGEB(PG8_SB(0, 1), b2 + hstep, voffB);
            PG8_WAIT_V(6); PG8_BAR; PG8_MMA(1, 1, At, B1); PG8_BAR;
            PG8_LDB(B0, 1, 0); PG8_SCHED; PG8_LDA(At, 1, 0); PG8_STAGEA(PG8_SA(0, 1), a2 + hstepA, voffA);
            PG8_WAIT_L(8); PG8_BAR; PG8_WAIT_L(0); PG8_MMA(0, 0, At, B0); PG8_BAR; PG8_SCHED;
            PG8_LDB(B1, 1, 1); PG8_STAGEB(PG8_SB(1, 0), b3, voffB);
            PG8_BAR; PG8_WAIT_L(0); PG8_MMA(0, 1, At, B1); PG8_BAR;
            PG8_LDA(At, 1, 1); PG8_STAGEA(PG8_SA(1, 0), a3, voffA);
            PG8_BAR; PG8_WAIT_L(0); PG8_MMA(1, 0, At, B0); PG8_BAR; PG8_SCHED;
            PG8_STAGEB(PG8_SB(1, 1), b3 + hstep, voffB);
            PG8_WAIT_V(6); PG8_BAR; PG8_MMA(1, 1, At, B1); PG8_BAR;
            }
        }
        }
        if constexpr (ALIGN_EPI) { if (wr == 0) PG8_BAR; }
        if constexpr (!Epi::AFTER_DRAIN) { const int l2 = lane_asm();
            E(acc, cur, wr, wc, l2 & 15, l2 >> 4); S.done(cur); }
        if (!has_next) break;
#pragma unroll
        for (int a = 0; a < 2; ++a)
#pragma unroll
            for (int b = 0; b < 2; ++b)
#pragma unroll
                for (int m = 0; m < 4; ++m)
#pragma unroll
                    for (int n = 0; n < 2; ++n) acc[a][b][m][n] = (f32x4){0.f, 0.f, 0.f, 0.f};
        cur = nxt; cA = nA; cB = nB; ++ui;
        if constexpr (ALIGN_EPI) { if (wr == 1) PG8_BAR; }
    }
    PG8_WAIT_V(0);
    if constexpr (!ALIGN_EPI) { if (wr == 0) PG8_BAR; }
    PG8_BAR;
    if constexpr (Epi::AFTER_DRAIN) { E.fused(acc, cur, wr, wc, fr, fq, lds, wid, lane); S.done(cur); }
#undef PG8_SA
#undef PG8_SB
#undef PG8_STAGE_
#undef PG8_STAGEA
#undef PG8_STAGEB
#undef PG8_LDA
#undef PG8_LDB
#undef PG8_MMA
#undef PG8_CAT
#undef PG8_LD8
#undef PG8_WAIT_V
#undef PG8_WAIT_L
#undef PG8_BAR
#undef PG8_SCHED
#undef PG8_KITER_SP2
}
}

#ifndef MK_PER_PHASE
#define MK_PER_PHASE 0
#endif
#ifndef LDSMM_SCALAR
#define LDSMM_SCALAR 0
#endif

#ifndef PROBE
#define PROBE 0
#endif
#ifndef AT_FP8
#define AT_FP8 1
#endif
#ifndef S5_FP8
#define S5_FP8 1
#endif
constexpr int NWAVES = 8, NTHR = 512;
constexpr int T = 16384, D = 1024, SEQ = 4096, NB = 4;
constexpr int FFD = 2816, FFE = 3584, NEXP = 8;
constexpr int MAXSLOT = 34816, MAXPANEL = 136;
constexpr float EPS = 1e-6f;

constexpr size_t MiB = 1u << 20;
constexpr size_t WS_CTL = 0, CTL_ZERO_BYTES = 32768;
constexpr size_t WS_TAB = 1 * MiB;
constexpr size_t TAB_GATES = WS_TAB;
constexpr size_t TAB_BC = WS_TAB + 1 * MiB;
constexpr size_t TAB_PC = TAB_BC + 8192, TAB_MPREV = TAB_PC + 8192;
constexpr size_t TAB_NU = WS_TAB + 2 * MiB;
constexpr size_t TAB_NS = WS_TAB + 3 * MiB;
constexpr size_t TAB_MOE = WS_TAB + 4 * MiB;
constexpr size_t MOE_TE = 0, MOE_TW = 65536, MOE_SLOT = 196608, MOE_GW = 327680, MOE_CNT = 524288, MOE_PANEL = 532480;
constexpr size_t WS_W = 8 * MiB;
constexpr size_t W_ML_IN = WS_W, W_ML_OUT = WS_W + 12 * MiB, W_AT_IN = WS_W + 16 * MiB, W_AT_OUT = WS_W + 22 * MiB, W_S5_IN = WS_W + 24 * MiB, W_S5_OUT = WS_W + 26 * MiB;
constexpr size_t W_FF_GU = WS_W + 30 * MiB, W_FF_D = WS_W + 52 * MiB, W_MOE_GU = WS_W + 63 * MiB, W_MOE_D = WS_W + 175 * MiB;
constexpr size_t SZ_ML_IN = 6 * MiB, SZ_ML_OUT = 2 * MiB, SZ_FF_GU = 11 * MiB, SZ_FF_D = (size_t)D * FFD * 2, SZ_MOE_GU = 7 * MiB, SZ_MOE_D = 7 * MiB / 2;
constexpr size_t WS_X = 407 * MiB, WS_X8 = 439 * MiB, WS_SSQ = 455 * MiB, WS_XN = 471 * MiB, WS_R = 503 * MiB;
constexpr size_t WS_PROJ = WS_R, WS_U32 = WS_R, WS_H = WS_R, WS_QKC = WS_R + 96 * MiB, WS_UC = WS_R + 128 * MiB, WS_CS = WS_R + 192 * MiB, WS_G = WS_R + 256 * MiB;
constexpr size_t WS_XG = WS_R + 238 * MiB, WS_Y = WS_XG, WS_END = WS_R + 306 * MiB;
static_assert(W_FF_D + 2 * SZ_FF_D <= W_MOE_GU && W_MOE_GU + 16 * SZ_MOE_GU == W_MOE_D && W_MOE_D + 16 * SZ_MOE_D <= WS_X, "weight map");
static_assert((size_t)MAXSLOT * FFE * 2 <= 238 * MiB && (size_t)MAXSLOT * D * 2 <= 68 * MiB, "MoE buffers");

constexpr int CW_TMO = 0;
constexpr int CW_BAR = 4096;

constexpr int RING_BYTES = 131072;
constexpr int MISC_OFF = RING_BYTES + 320;
constexpr int LDS_BYTES = 147456;

#define GAS __attribute__((address_space(1)))
#define LAS __attribute__((address_space(3)))
typedef unsigned short bf16;
typedef unsigned v4u __attribute__((ext_vector_type(4)));
typedef unsigned v2u __attribute__((ext_vector_type(2)));
typedef float f32x4 __attribute__((ext_vector_type(4)));
typedef short bf16x8 __attribute__((ext_vector_type(8)));
using pg8::sigmoidf_;
#define LDS_WAIT() asm volatile("s_waitcnt lgkmcnt(0)" ::: "memory")
__device__ __forceinline__ unsigned f2bf(float f) { unsigned u = __builtin_bit_cast(unsigned, f); return (u + 0x7fffu + ((u >> 16) & 1u)) >> 16; }
typedef __bf16 bf16x2_t __attribute__((ext_vector_type(2)));
typedef float f32x2_t __attribute__((ext_vector_type(2)));
__device__ __forceinline__ unsigned pk2(float lo, float hi) { const f32x2_t v = {lo, hi}; return __builtin_bit_cast(unsigned, __builtin_convertvector(v, bf16x2_t)); }
__device__ __forceinline__ float bf2f(unsigned v) { return __builtin_bit_cast(float, v << 16); }
__device__ __forceinline__ float bflo(unsigned w) { return __builtin_bit_cast(float, w << 16); }
__device__ __forceinline__ float bfhi(unsigned w) { return __builtin_bit_cast(float, w & 0xffff0000u); }
__device__ __forceinline__ float wave_sum(float v) {
#pragma unroll
    for (int o = 1; o < 64; o <<= 1) v += __shfl_xor(v, o);
    return v;
}
__device__ __forceinline__ float wave_max(float v) {
#pragma unroll
    for (int o = 1; o < 64; o <<= 1) v = fmaxf(v, __shfl_xor(v, o));
    return v;
}

#define XB_TMO      128
#define XB_XCNT(j)  (256  + 64 * (j))
#define XB_XSUB(j)  (1280 + 64 * (j))
#define XB_XGEN(j)  (2304 + 64 * (j))
#define XB_TOP      3328
#define XB_TOPGEN   3392
#define XCD_BAR_WORDS 3456
#define XB_SPIN_CAP (1u << 18)

__device__ __forceinline__ unsigned xb_ld(unsigned* p)              { return __hip_atomic_load(p, __ATOMIC_RELAXED, __HIP_MEMORY_SCOPE_AGENT); }
__device__ __forceinline__ unsigned xb_add(unsigned* p, unsigned v) { return __hip_atomic_fetch_add(p, v, __ATOMIC_RELAXED, __HIP_MEMORY_SCOPE_AGENT); }
__device__ __forceinline__ unsigned xb_xcc_id() { return (unsigned)__builtin_amdgcn_s_getreg((3 << 11) | 20) & 0xFu; }
#define XB_SPIN(cond, bar) do { unsigned _sp = 0; while (cond) { __builtin_amdgcn_s_sleep(1); \
    if ((++_sp & 255u) == 0u) { if (xb_ld(&(bar)[XB_TMO])) break; if (_sp > XB_SPIN_CAP) { atomicAdd(&(bar)[XB_TMO], 1u); break; } } } } while (0)

struct XcdBarrier {
    unsigned* bar; unsigned x; int wave;
    volatile LAS unsigned* st;
};

__device__ __forceinline__ XcdBarrier xcd_barrier_post(unsigned* bar, volatile LAS unsigned* st, int wave) {
    XcdBarrier b; b.bar = bar; b.x = xb_xcc_id(); b.st = st; b.wave = wave;
    if (wave == 0 && pg8::lane_asm() == 0) (void)xb_add(&bar[XB_XCNT(b.x)], 1u);
    return b;
}
__device__ __forceinline__ void xcd_barrier_complete(unsigned* bar, unsigned x, unsigned& nloc, unsigned& nx) {
    const unsigned G = gridDim.x * gridDim.y * gridDim.z;
    unsigned sum, cnt, mine, sp = 0u;
    for (;;) {
        sum = 0u; cnt = 0u; mine = 0u;
#pragma unroll
        for (unsigned j = 0; j < 16; ++j) { const unsigned c = xb_ld(&bar[XB_XCNT(j)]); sum += c; cnt += (c > 0u) ? 1u : 0u; mine = (j == x) ? c : mine; }
        if (sum == G) break;
        __builtin_amdgcn_s_sleep(1);
        if ((++sp & 255u) == 0u) { if (xb_ld(&bar[XB_TMO])) break; if (sp > XB_SPIN_CAP) { atomicAdd(&bar[XB_TMO], 1u); break; } }
    }
    nloc = mine > 0u ? mine : 1u; nx = cnt > 0u ? cnt : 1u;
}

__device__ __forceinline__ void xcd_barrier(const XcdBarrier& b) {
    asm volatile("s_waitcnt vmcnt(0)" ::: "memory");
    __syncthreads();
    if (b.wave == 0 && pg8::lane_asm() == 0) {
        unsigned* bar = b.bar;
        __builtin_amdgcn_s_waitcnt(0);
        unsigned nloc = b.st[0], nx = b.st[1];
        if (nloc == 0u) { xcd_barrier_complete(bar, b.x, nloc, nx); b.st[0] = nloc; b.st[1] = nx; }
        const unsigned old = xb_add(&bar[XB_XSUB(b.x)], 1u);
        const unsigned gen = old / nloc;
        if (old + 1u == (gen + 1u) * nloc) {
            __builtin_amdgcn_fence(__ATOMIC_RELEASE, "agent");
            asm volatile("s_waitcnt vmcnt(0)" ::: "memory");
            const unsigned og = xb_add(&bar[XB_TOP], 1u);
            const unsigned tg = og / nx;
            if (og + 1u == (tg + 1u) * nx) xb_add(&bar[XB_TOPGEN], 1u);
            else XB_SPIN(xb_ld(&bar[XB_TOPGEN]) == tg, bar);
            __builtin_amdgcn_fence(__ATOMIC_ACQUIRE, "agent");
            xb_add(&bar[XB_XGEN(b.x)], 1u);
            asm volatile("s_waitcnt vmcnt(0)" ::: "memory");
        } else {
            XB_SPIN(xb_ld(&bar[XB_XGEN(b.x)]) == gen, bar);
            __builtin_amdgcn_fence(__ATOMIC_ACQUIRE, "agent");
            asm volatile("s_waitcnt vmcnt(0)" ::: "memory");
        }
    }
    __syncthreads();
}

typedef short s16x4 __attribute__((ext_vector_type(4)));
__device__ __forceinline__ s16x4 lds_tr16(const LAS bf16* p) { return __builtin_bit_cast(s16x4, __builtin_amdgcn_ds_read_tr16_b64_v4i16((LAS s16x4*)p)); }
template <bool TR>
__device__ __forceinline__ bf16x8 ldfrag(const LAS bf16* base, int ld, int x0, int k0, int lane) {
    if constexpr (!TR) { return *(const LAS bf16x8*)(base + (x0 + (lane & 15)) * ld + k0 + 8 * (lane >> 4)); }
    else { const int i = lane & 15, g = lane >> 4; const LAS bf16* p = base + (k0 + 8 * g + (i >> 2)) * ld + x0 + 4 * (i & 3);
        const s16x4 a = lds_tr16(p), b = lds_tr16(p + 4 * ld); return (bf16x8){a[0], a[1], a[2], a[3], b[0], b[1], b[2], b[3]}; }
}
template <int M, int N, int K1, bool TRA1, bool TRB1, int K2, int TN, class F>
__device__ __forceinline__ void lds_mmx(const LAS bf16* A1, int lda1, const LAS bf16* B1, int ldb1,
                                        const LAS bf16* A2, int lda2, const LAS bf16* B2, int ldb2, int wave, int lane, const F& f) {
    constexpr int MT = M / 16, NG = N / (16 * TN);
    static_assert(M % 16 == 0 && N % (16 * TN) == 0 && K1 % 32 == 0 && K2 % 32 == 0, "lds_mmx shape");
    for (int grp = wave; grp < MT * NG; grp += NWAVES) {
        const int mt = grp / NG, ng = grp - mt * NG;
        f32x4 acc[TN];
#pragma unroll
        for (int t = 0; t < TN; ++t) acc[t] = (f32x4){0.f, 0.f, 0.f, 0.f};
#pragma unroll
        for (int k = 0; k < K1; k += 32) { const bf16x8 a = ldfrag<TRA1>(A1, lda1, mt * 16, k, lane);
#pragma unroll
            for (int t = 0; t < TN; ++t) acc[t] = __builtin_amdgcn_mfma_f32_16x16x32_bf16(a, ldfrag<TRB1>(B1, ldb1, (ng * TN + t) * 16, k, lane), acc[t], 0, 0, 0); }
        if constexpr (K2 > 0) {
#pragma unroll
            for (int k = 0; k < K2; k += 32) { const bf16x8 a = ldfrag<false>(A2, lda2, mt * 16, k, lane);
#pragma unroll
                for (int t = 0; t < TN; ++t) acc[t] = __builtin_amdgcn_mfma_f32_16x16x32_bf16(a, ldfrag<false>(B2, ldb2, (ng * TN + t) * 16, k, lane), acc[t], 0, 0, 0); } }
#pragma unroll
        for (int t = 0; t < TN; ++t) f(mt * 16 + 4 * (lane >> 4), (ng * TN + t) * 16 + (lane & 15), acc[t]);
    }
}
template <int M, int N, int K1, bool TRA1, int K2, int TN, class F>
__device__ __forceinline__ void lds_mmx2(const LAS bf16* A1, int lda1, const LAS bf16* B1, int ldb1,
                                         const LAS bf16* A2, int lda2, const LAS bf16* B2, int ldb2, int wave, int lane, const F& f) {
    constexpr int MT = M / 16, NG = N / (16 * TN);
    for (int grp = wave; grp < MT * NG; grp += NWAVES) {
        const int mt = grp / NG, ng = grp - mt * NG;
        f32x4 acc1[TN], acc2[TN];
#pragma unroll
        for (int t = 0; t < TN; ++t) { acc1[t] = (f32x4){0.f, 0.f, 0.f, 0.f}; acc2[t] = (f32x4){0.f, 0.f, 0.f, 0.f}; }
#pragma unroll
        for (int k = 0; k < K1; k += 32) { const bf16x8 a = ldfrag<TRA1>(A1, lda1, mt * 16, k, lane);
#pragma unroll
            for (int t = 0; t < TN; ++t) acc1[t] = __builtin_amdgcn_mfma_f32_16x16x32_bf16(a, ldfrag<false>(B1, ldb1, (ng * TN + t) * 16, k, lane), acc1[t], 0, 0, 0); }
#pragma unroll
        for (int k = 0; k < K2; k += 32) { const bf16x8 a = ldfrag<false>(A2, lda2, mt * 16, k, lane);
#pragma unroll
            for (int t = 0; t < TN; ++t) acc2[t] = __builtin_amdgcn_mfma_f32_16x16x32_bf16(a, ldfrag<false>(B2, ldb2, (ng * TN + t) * 16, k, lane), acc2[t], 0, 0, 0); }
#pragma unroll
        for (int t = 0; t < TN; ++t) f(mt * 16 + 4 * (lane >> 4), (ng * TN + t) * 16 + (lane & 15), acc1[t], acc2[t]);
    }
}
__device__ __forceinline__ v2u pack4(f32x4 v) { v2u w; w.x = pk2(v.x, v.y); w.y = pk2(v.z, v.w); return w; }

struct Ctx { LAS unsigned char* lds; int tid, lane, wave, blk, G; };

struct Job { const float* src; bf16* dst; const float* gain; int K, N, ldw, mode, item0, pad; };
constexpr int NJOBS = 64;
__device__ __forceinline__ void tr_item(const GAS float* W, int K, int ldw, int nblk, GAS bf16* WT, int mode, LAS bf16* scr, int item, int lane, const float* gain) {
    const int kb = item / nblk, nb = item - kb * nblk, k0 = 64 * kb, n0 = 64 * nb;
    const int lr = lane >> 4, lc = (lane & 15) * 4;
    f32x4 v[16];
    const GAS float* src = W + (size_t)(k0 + 2 * lr) * ldw + n0 + lc;
#pragma unroll
    for (int i = 0; i < 8; ++i) { v[2 * i] = __builtin_nontemporal_load((const GAS f32x4*)(src + (size_t)(8 * i) * ldw)); v[2 * i + 1] = __builtin_nontemporal_load((const GAS f32x4*)(src + (size_t)(8 * i + 1) * ldw)); }
    if (gain) {
#pragma unroll
        for (int i = 0; i < 8; ++i) { v[2 * i] *= gain[k0 + 2 * lr + 8 * i]; v[2 * i + 1] *= gain[k0 + 2 * lr + 8 * i + 1]; } }
#pragma unroll
    for (int i = 0; i < 8; ++i) { LAS unsigned* d = (LAS unsigned*)(scr + lc * 72 + 8 * i + 2 * lr);
        d[0] = pk2(v[2 * i].x, v[2 * i + 1].x); d[36] = pk2(v[2 * i].y, v[2 * i + 1].y); d[72] = pk2(v[2 * i].z, v[2 * i + 1].z); d[108] = pk2(v[2 * i].w, v[2 * i + 1].w); }
    LDS_WAIT(); asm volatile("" ::: "memory");
    const int drow0 = (mode == 0) ? n0 : (256 * (n0 >> 7) + (n0 & 127) + (mode == 2 ? 128 : 0));
    const int c = lane & 7;
#pragma unroll
    for (int j = 0; j < 8; ++j) { const int n = (lane >> 3) + 8 * j; const v4u o = *(const LAS v4u*)(scr + n * 72 + 8 * c);
        __builtin_nontemporal_store(o, (GAS v4u*)(WT + (size_t)(drow0 + n) * K + k0 + 8 * c)); }
    LDS_WAIT(); asm volatile("" ::: "memory");
}
__device__ __forceinline__ void tr_item8(const GAS float* W, int K, int ldw, int nblk, GAS unsigned char* WT, int mode, float scale, LAS unsigned char* scr, int item, int lane, const float* gain) {
    const int kb = item / nblk, nb = item - kb * nblk, k0 = 128 * kb, n0 = 64 * nb;
    const int lr = lane >> 4, lc = (lane & 15) * 4;
#pragma unroll
    for (int hh = 0; hh < 2; ++hh) {
        f32x4 v[16];
        const GAS float* src = W + (size_t)(k0 + 64 * hh + 4 * lr) * ldw + n0 + lc;
#pragma unroll
        for (int i = 0; i < 4; ++i)
#pragma unroll
            for (int r = 0; r < 4; ++r) v[4 * i + r] = __builtin_nontemporal_load((const GAS f32x4*)(src + (size_t)(16 * i + r) * ldw));
        if (gain) {
#pragma unroll
            for (int i = 0; i < 4; ++i)
#pragma unroll
                for (int r = 0; r < 4; ++r) v[4 * i + r] *= gain[k0 + 64 * hh + 4 * lr + 16 * i + r]; }
#pragma unroll
        for (int i = 0; i < 4; ++i) { LAS unsigned* d = (LAS unsigned*)(scr + lc * 144 + 64 * hh + 16 * i + 4 * lr);
            d[0] = pg8::cvt4_fp8(v[4 * i].x * scale, v[4 * i + 1].x * scale, v[4 * i + 2].x * scale, v[4 * i + 3].x * scale);
            d[36] = pg8::cvt4_fp8(v[4 * i].y * scale, v[4 * i + 1].y * scale, v[4 * i + 2].y * scale, v[4 * i + 3].y * scale);
            d[72] = pg8::cvt4_fp8(v[4 * i].z * scale, v[4 * i + 1].z * scale, v[4 * i + 2].z * scale, v[4 * i + 3].z * scale);
            d[108] = pg8::cvt4_fp8(v[4 * i].w * scale, v[4 * i + 1].w * scale, v[4 * i + 2].w * scale, v[4 * i + 3].w * scale); }
    }
    LDS_WAIT(); asm volatile("" ::: "memory");
    const int drow0 = (mode == 0) ? n0 : (256 * (n0 >> 7) + (n0 & 127) + (mode == 2 ? 128 : 0));
    const int c = lane & 7;
#pragma unroll
    for (int j = 0; j < 8; ++j) { const int n = (lane >> 3) + 8 * j; const v4u o = *(const LAS v4u*)(scr + n * 144 + 16 * c);
        __builtin_nontemporal_store(o, (GAS v4u*)(WT + (size_t)(drow0 + n) * K + k0 + 16 * c)); }
    LDS_WAIT(); asm volatile("" ::: "memory");
}
constexpr int CV_ABS1 = 3072, CV_ABS2 = 3584, CV_ABS3 = 2048;
__device__ __forceinline__ void convert_phase(const Ctx& C, const float* const* in, unsigned char* ws, int part, int worker, int nworkers) {
    LAS Job* jobs = (LAS Job*)(C.lds + 0);
    LAS int* njobs_p = (LAS int*)(C.lds + 4096);
    LAS bf16* scr = (LAS bf16*)(C.lds + 8192 + C.wave * 9216);
    if (C.tid == 0) {
        int nj = 0, it = 0;
        auto add = [&](const float* src, bf16* dst, int K, int N, int ldw, int mode, const float* gain = nullptr) {
            jobs[nj].src = src; jobs[nj].dst = dst; jobs[nj].gain = gain; jobs[nj].K = K; jobs[nj].N = N; jobs[nj].ldw = ldw; jobs[nj].mode = mode; jobs[nj].item0 = it; jobs[nj].pad = 0;
            it += (mode & 4) ? (K / 128) * (N / 64) : (K / 64) * (N / 64); ++nj; };
        for (int j = 0; j < 2; ++j) {
            add(in[4] + (size_t)j * D * 3080, (bf16*)(ws + W_ML_IN + j * SZ_ML_IN), D, 3072, 3080, j ? 4 : 0);
            add(in[8] + (size_t)j * D * D, (bf16*)(ws + W_ML_OUT + j * SZ_ML_OUT), D, D, D, j ? 4 : 0);
        }
        add(in[9], (bf16*)(ws + W_AT_IN), D, 3072, 3072, AT_FP8 ? 4 : 0, in[1] + 1 * D);
        add(in[11], (bf16*)(ws + W_AT_OUT), D, D, D, AT_FP8 ? 4 : 0);
        add(in[12], (bf16*)(ws + W_S5_IN), D, D, D, S5_FP8 ? 4 : 0);
        add(in[21], (bf16*)(ws + W_S5_OUT), D, D, 2048, 1 | (S5_FP8 ? 4 : 0));
        add(in[21] + D, (bf16*)(ws + W_S5_OUT), D, D, 2048, 2 | (S5_FP8 ? 4 : 0));
        for (int f = 0; f < 2; ++f) {
            add(in[22] + (size_t)f * D * FFD, (bf16*)(ws + W_FF_GU + f * SZ_FF_GU), D, FFD, FFD, 1 | (f ? 4 : 0), in[2] + 2 * f * D);
            add(in[23] + (size_t)f * D * FFD, (bf16*)(ws + W_FF_GU + f * SZ_FF_GU), D, FFD, FFD, 2 | (f ? 4 : 0), in[2] + 2 * f * D);
            add(in[24] + (size_t)f * FFD * D, (bf16*)(ws + W_FF_D + f * SZ_FF_D), FFD, D, D, 0 | (f ? 4 : 0));
        }
        for (int fe = 0; fe < 16; ++fe) {
            add(in[27] + (size_t)fe * D * FFE, (bf16*)(ws + W_MOE_GU + fe * SZ_MOE_GU), D, FFE, FFE, 1 | 4);
            add(in[28] + (size_t)fe * D * FFE, (bf16*)(ws + W_MOE_GU + fe * SZ_MOE_GU), D, FFE, FFE, 2 | 4);
            add(in[29] + (size_t)fe * FFE * D, (bf16*)(ws + W_MOE_D + fe * SZ_MOE_D), FFE, D, D, 0 | 4);
        }
        jobs[nj].item0 = it; *njobs_p = nj;
    }
    __syncthreads();
    const int nj = *njobs_p; const int total = jobs[nj].item0;
    const int e3 = total - CV_ABS1 - CV_ABS2, b3 = e3 - CV_ABS3;
    const int lo = part == 0 ? 0 : (part == 3 ? b3 : (part == 1 ? e3 : total - CV_ABS2)), hi = part == 0 ? b3 : (part == 3 ? e3 : (part == 1 ? total - CV_ABS2 : total));
    int j = 0;
    for (int it = lo + worker; it < hi; it += nworkers) {
        while (jobs[j + 1].item0 <= it) ++j;
        const float* src = jobs[j].src; bf16* dst = jobs[j].dst; const float* gain = jobs[j].gain; const int K = jobs[j].K, N = jobs[j].N, ldw = jobs[j].ldw, mode = jobs[j].mode, i0 = jobs[j].item0;
        if (mode & 4) tr_item8((const GAS float*)src, K, ldw, N / 64, (GAS unsigned char*)dst, mode & 3, 64.f, (LAS unsigned char*)scr, it - i0, C.lane, gain);
        else tr_item((const GAS float*)src, K, ldw, N / 64, (GAS bf16*)dst, mode, scr, it - i0, C.lane, gain);
    }
    __syncthreads();
}

__device__ __forceinline__ float log_sigmoid(float x) { return fminf(x, 0.f) - log1pf(__expf(-fabsf(x))); }
__device__ __forceinline__ float wave_sum8(const float (&p)[8], int lane) {
    float a[4], b[2], c0;
    { const bool hi = lane & 1;
#pragma unroll
      for (int i = 0; i < 4; ++i) { const float mine = hi ? p[4 + i] : p[i], give = hi ? p[i] : p[4 + i]; a[i] = mine + __shfl_xor(give, 1); } }
    { const bool hi = lane & 2;
#pragma unroll
      for (int i = 0; i < 2; ++i) { const float mine = hi ? a[2 + i] : a[i], give = hi ? a[i] : a[2 + i]; b[i] = mine + __shfl_xor(give, 2); } }
    { const bool hi = lane & 4; const float mine = hi ? b[1] : b[0], give = hi ? b[0] : b[1]; c0 = mine + __shfl_xor(give, 4); }
    c0 += __shfl_xor(c0, 8); c0 += __shfl_xor(c0, 16); c0 += __shfl_xor(c0, 32);
    return c0;
}
__device__ __forceinline__ int sum8_index(int lane) { return 4 * (lane & 1) + 2 * ((lane >> 1) & 1) + ((lane >> 2) & 1); }
__device__ __forceinline__ f32x4 ldx4(const bf16* row, int idx) { const v2u r = ((const v2u*)row)[idx]; return (f32x4){bflo(r.x), bfhi(r.x), bflo(r.y), bfhi(r.y)}; }
__device__ __forceinline__ void load_w8(const Ctx& C, const float* src, int stride, f32x4 (&wg)[32]) {
    LAS f32x4* wl = (LAS f32x4*)(C.lds);
    for (int k = C.tid; k < 1024; k += NTHR) { const float* wp = src + (size_t)k * stride; const int q = (k & 3) * 256 + (k >> 2);
        wl[2 * q] = *(const f32x4*)wp; wl[2 * q + 1] = *(const f32x4*)(wp + 4); }
    __syncthreads();
#pragma unroll
    for (int j = 0; j < 4; ++j)
#pragma unroll
        for (int cc = 0; cc < 4; ++cc) { const int q = cc * 256 + 64 * j + C.lane; wg[(4 * j + cc) * 2] = wl[2 * q]; wg[(4 * j + cc) * 2 + 1] = wl[2 * q + 1]; }
    __syncthreads();
}
template <bool GATES, bool FP8OUT = false, bool XBF = true>
__device__ __forceinline__ void norm_phase(const Ctx& C, const void* xin_, const float* gain, bf16* out, const float* w_in, const float* b_if, float* gates_out) {
    f32x4 wg[GATES ? 32 : 1];
    if constexpr (GATES) load_w8(C, w_in + 3072, 3080, wg);
    const int gw = C.blk * NWAVES + C.wave, NGW = C.G * NWAVES;
    f32x4 g[4];
#pragma unroll
    for (int j = 0; j < 4; ++j) g[j] = ((const f32x4*)gain)[C.lane + 64 * j];
    f32x4 nx[4];
    const float* xin = (const float*)xin_; const bf16* xinb = (const bf16*)xin_;
    if (gw < T) {
        if constexpr (XBF) {
#pragma unroll
            for (int j = 0; j < 4; ++j) nx[j] = ldx4(xinb + (size_t)gw * D, C.lane + 64 * j);
        } else { const f32x4* xr = (const f32x4*)(xin + (size_t)gw * D) + C.lane;
#pragma unroll
            for (int j = 0; j < 4; ++j) nx[j] = xr[64 * j]; } }
    for (int m = gw; m < T; m += NGW) {
        f32x4 v[4]; float ss = 0.f;
#pragma unroll
        for (int j = 0; j < 4; ++j) v[j] = nx[j];
        if (m + NGW < T) {
            if constexpr (XBF) {
#pragma unroll
                for (int j = 0; j < 4; ++j) nx[j] = ldx4(xinb + (size_t)(m + NGW) * D, C.lane + 64 * j);
            } else { const f32x4* xr = (const f32x4*)(xin + (size_t)(m + NGW) * D) + C.lane;
#pragma unroll
                for (int j = 0; j < 4; ++j) nx[j] = xr[64 * j]; } }
#pragma unroll
        for (int j = 0; j < 4; ++j) ss += (v[j].x * v[j].x + v[j].y * v[j].y) + (v[j].z * v[j].z + v[j].w * v[j].w);
        const float inv = rsqrtf(wave_sum(ss) * (1.f / D) + EPS);
        if constexpr (FP8OUT) { unsigned* o4 = (unsigned*)((unsigned char*)out + (size_t)m * D) + C.lane;
#pragma unroll
            for (int j = 0; j < 4; ++j) { v[j] = v[j] * inv * g[j]; o4[64 * j] = pg8::cvt4_fp8(v[j].x, v[j].y, v[j].z, v[j].w); }
        } else { unsigned long long* o8 = (unsigned long long*)(out + (size_t)m * D) + C.lane;
#pragma unroll
            for (int j = 0; j < 4; ++j) { v[j] = v[j] * inv * g[j]; o8[64 * j] = (unsigned long long)pk2(v[j].x, v[j].y) | ((unsigned long long)pk2(v[j].z, v[j].w) << 32); } }
        if constexpr (GATES) {
            float p[8];
#pragma unroll
            for (int i = 0; i < 8; ++i) p[i] = 0.f;
#pragma unroll
            for (int j = 0; j < 4; ++j)
#pragma unroll
                for (int c = 0; c < 4; ++c) { const f32x4 w0 = wg[(4 * j + c) * 2], w1 = wg[(4 * j + c) * 2 + 1]; const float h = v[j][c];
                    p[0] += h * w0.x; p[1] += h * w0.y; p[2] += h * w0.z; p[3] += h * w0.w; p[4] += h * w1.x; p[5] += h * w1.y; p[6] += h * w1.z; p[7] += h * w1.w; }
            const float tot = wave_sum8(p, C.lane); const int gi = sum8_index(C.lane);
            if (C.lane < 8) { float val = tot + b_if[gi]; if (gi >= 4) val = log_sigmoid(val); gates_out[(size_t)m * 8 + gi] = val; }
        }
    }
}

__device__ __forceinline__ float wave_incl_scan_add(float v, int lane) {
#pragma unroll
    for (int o = 1; o < 64; o <<= 1) { const float t = __shfl_up(v, o); if (lane >= o) v += t; }
    return v;
}
__device__ __forceinline__ float wave_incl_scan_max(float v, int lane) {
#pragma unroll
    for (int o = 1; o < 64; o <<= 1) { const float t = __shfl_up(v, o); if (lane >= o) v = fmaxf(v, t); }
    return v;
}
__device__ __forceinline__ void ml_m1(const Ctx& C, const bf16* PROJ, const float* gates, const float* convw, bf16* QKC, bf16* PL, bf16* GT, float* NLOC, float* NT,
                                      float* MPREV, float* DELTA, float* DG) {
    LAS bf16* Kn = (LAS bf16*)(C.lds);
    LAS bf16* Vn = (LAS bf16*)(C.lds + 17408);
    LAS float* wk = (LAS float*)(C.lds + 51200);
    LAS float* BtL = wk + 64; LAS float* PtL = wk + 128; LAS float* decL = wk + 192; LAS float* mprevL = wk + 256; LAS float* mxL = wk + 320;
    const int cg = C.tid & 31, s_base = C.tid >> 5; const bool isk = cg >= 16;
    const int r16 = C.lane & 15, q4 = C.lane >> 4;
    v4u praw[7], vraw[4]; float ig_ = 0.f, lf_ = 0.f;
    LAS f32x4* cwL = (LAS f32x4*)(C.lds + 53248);
#define M1_ISSUE(uu) do { const int bh_ = (uu) >> 6, c_ = (uu) & 63, b_ = bh_ >> 2, h_ = bh_ & 3; const int t0_ = b_ * SEQ + c_ * 64; \
        const int col_ = isk ? (512 + h_ * 128 + (cg - 16) * 8) : (h_ * 128 + cg * 8); \
        _Pragma("unroll") for (int r_ = 0; r_ < 7; ++r_) { const int sp_ = c_ * 64 + 4 * s_base - 3 + r_; \
            praw[r_] = (sp_ >= 0) ? *(const v4u*)(PROJ + (size_t)(b_ * SEQ + sp_) * 3072 + col_) : (v4u){0u, 0u, 0u, 0u}; } \
        _Pragma("unroll") for (int i_ = 0; i_ < 4; ++i_) vraw[i_] = *(const v4u*)(PROJ + (size_t)(t0_ + s_base + 16 * i_) * 3072 + 1024 + h_ * 256 + cg * 8); \
        if (C.wave == 0) { ig_ = gates[(size_t)(t0_ + C.lane) * 8 + h_]; lf_ = gates[(size_t)(t0_ + C.lane) * 8 + 4 + h_]; } } while (0)
    for (int gu = C.blk; gu < 256; gu += C.G) {
        const int bh = gu >> 4, gq = gu & 15, b = bh >> 2, h = bh & 3;
        M1_ISSUE(bh * 64 + 4 * gq);
        if (s_base == 0) { const int colw = isk ? (512 + h * 128 + (cg - 16) * 8) : (h * 128 + cg * 8);
#pragma unroll
            for (int jj = 0; jj < 4; ++jj) { cwL[cg * 8 + 2 * jj] = *(const f32x4*)(convw + jj * 1024 + colw); cwL[cg * 8 + 2 * jj + 1] = *(const f32x4*)(convw + jj * 1024 + colw + 4); } }
#pragma unroll 1
        for (int i = 0; i < 8; ++i) { const int cc = C.wave * 8 + i; const int tt = b * SEQ + cc * 64 + C.lane;
            const float ig = gates[(size_t)tt * 8 + h], lf = gates[(size_t)tt * 8 + 4 + h];
            const float bc = wave_incl_scan_add(lf, C.lane); const float P = wave_max(ig - bc); const float B = __shfl(bc, 63);
            if (C.lane == 0) { BtL[cc] = B; PtL[cc] = P; } }
        __syncthreads();
        if (C.tid == 0) { float m = 0.f;
            for (int cc = 0; cc < 64; ++cc) { const float mx = fmaxf(m, PtL[cc]); mprevL[cc] = m; mxL[cc] = mx; decL[cc] = __expf(m - mx); m = BtL[cc] + mx; } }
        __syncthreads();
        f32x4 acc[16];
#pragma unroll
        for (int t = 0; t < 16; ++t) acc[t] = (f32x4){0.f, 0.f, 0.f, 0.f};
        float nacc = 0.f, delta = 1.f;
#pragma unroll 1
        for (int i = 0; i < 4; ++i) {
            int c = 4 * gq + i; asm volatile("" : "+s"(c));
            const int u = bh * 64 + c; const int t0 = b * SEQ + c * 64;
            const int col = isk ? (512 + h * 128 + (cg - 16) * 8) : (h * 128 + cg * 8);
            if (C.wave == 0) {
                const float bc = wave_incl_scan_add(lf_, C.lane); const float a = ig_ - bc;
                wk[C.lane] = __expf(a - mxL[c]);
                if (C.lane == 0) { MPREV[u] = mprevL[c]; DELTA[u] = delta; }
            }
#pragma unroll
            for (int k = 0; k < 4; ++k) *(LAS v4u*)(Vn + (s_base + 16 * k) * 264 + cg * 8) = vraw[k];
            __syncthreads();
#pragma unroll
            for (int k = 0; k < 4; ++k) { const int s = 4 * s_base + k;
                float cv[8];
#pragma unroll
                for (int e = 0; e < 8; ++e) cv[e] = 0.f;
#pragma unroll
                for (int jj = 0; jj < 4; ++jj) { const v4u raw = praw[k + jj]; const f32x4 w0 = cwL[cg * 8 + 2 * jj], w1 = cwL[cg * 8 + 2 * jj + 1];
                    cv[0] += bflo(raw.x) * w0.x; cv[1] += bfhi(raw.x) * w0.y; cv[2] += bflo(raw.y) * w0.z; cv[3] += bfhi(raw.y) * w0.w;
                    cv[4] += bflo(raw.z) * w1.x; cv[5] += bfhi(raw.z) * w1.y; cv[6] += bflo(raw.w) * w1.z; cv[7] += bfhi(raw.w) * w1.w; }
                const float sc = isk ? 0.08838834764831845f : 1.0f;
#pragma unroll
                for (int e = 0; e < 8; ++e) cv[e] = cv[e] * sigmoidf_(cv[e]) * sc;
                v4u o; o.x = pk2(cv[0], cv[1]); o.y = pk2(cv[2], cv[3]); o.z = pk2(cv[4], cv[5]); o.w = pk2(cv[6], cv[7]);
                *(v4u*)(QKC + (size_t)(t0 + s) * 1024 + col) = o;
                if (isk) { const float w = wk[s]; v4u ow; ow.x = pk2(cv[0] * w, cv[1] * w); ow.y = pk2(cv[2] * w, cv[3] * w); ow.z = pk2(cv[4] * w, cv[5] * w); ow.w = pk2(cv[6] * w, cv[7] * w);
                    *(LAS v4u*)(Kn + s * 136 + (cg - 16) * 8) = ow; } }
            if (i > 0) { bf16* pl = PL + (size_t)u * 32768 + C.wave * 16 + 4 * q4;
#pragma unroll
              for (int t = 0; t < 16; ++t) *(v2u*)(pl + (t * 16 + r16) * 128) = pack4(acc[t]); }
            if (C.tid < 128) NLOC[(size_t)u * 128 + C.tid] = nacc;
            __syncthreads();
            const float d = decL[c];
#pragma unroll
            for (int t = 0; t < 16; ++t) acc[t] *= d;
#pragma unroll
            for (int k = 0; k < 64; k += 32) { const bf16x8 a = ldfrag<true>(Kn, 136, C.wave * 16, k, C.lane);
#pragma unroll
                for (int t4 = 0; t4 < 16; t4 += 4) {
                    bf16x8 bq[4];
#pragma unroll
                    for (int t = 0; t < 4; ++t) bq[t] = ldfrag<true>(Vn, 264, (t4 + t) * 16, k, C.lane);
#pragma unroll
                    for (int t = 0; t < 4; ++t) acc[t4 + t] = __builtin_amdgcn_mfma_f32_16x16x32_bf16(a, bq[t], acc[t4 + t], 0, 0, 0);
                    __builtin_amdgcn_sched_barrier(0); } }
            if (C.tid < 128) { float sm = 0.f;
#pragma unroll 16
                for (int k = 0; k < 64; ++k) sm += bf2f(Kn[k * 136 + C.tid]);
                nacc = d * nacc + sm; }
            delta *= d;
            if (i + 1 < 4) M1_ISSUE(u + 1);
            __syncthreads();
        }
        { const int ln = pg8::lane_asm();
          bf16* gt = GT + (size_t)gu * 32768 + C.wave * 16 + 4 * (ln >> 4);
#pragma unroll
          for (int t = 0; t < 16; ++t) *(v2u*)(gt + (t * 16 + (ln & 15)) * 128) = pack4(acc[t]); }
        if (C.tid < 128) NT[(size_t)gu * 128 + C.tid] = nacc;
        if (C.tid == 0) DG[gu] = delta;
        __syncthreads();
    }
#undef M1_ISSUE
}
__device__ __forceinline__ void ml_m2(const Ctx& C, const bf16* GT, bf16* GS, const float* NT, float* NSg, const float* DG) {
    for (int wi = C.blk; wi < 256; wi += C.G) {
        const int bh = wi >> 4, slice = wi & 15;
        const size_t e0 = (size_t)slice * 2048 + (size_t)C.tid * 4;
        float dg[16]; v2u raw[16];
#pragma unroll
        for (int g = 0; g < 16; ++g) { dg[g] = DG[bh * 16 + g]; raw[g] = *(const v2u*)(GT + (size_t)(bh * 16 + g) * 32768 + e0); }
        float c0 = 0.f, c1 = 0.f, c2 = 0.f, c3 = 0.f;
#pragma unroll
        for (int g = 0; g < 16; ++g) { v2u o; o.x = pk2(c0, c1); o.y = pk2(c2, c3); *(v2u*)(GS + (size_t)(bh * 16 + g) * 32768 + e0) = o;
            const float d = dg[g];
            c0 = d * c0 + bflo(raw[g].x); c1 = d * c1 + bfhi(raw[g].x); c2 = d * c2 + bflo(raw[g].y); c3 = d * c3 + bfhi(raw[g].y); }
        if (slice == 0 && C.tid < 128) { float n = 0.f;
#pragma unroll
            for (int g = 0; g < 16; ++g) { NSg[(size_t)(bh * 16 + g) * 128 + C.tid] = n; n = dg[g] * n + NT[(size_t)(bh * 16 + g) * 128 + C.tid]; } }
    }
}
__device__ __forceinline__ v4u comb8(v4u p, v4u g, float d) {
    v4u o; o.x = pk2(bflo(p.x) + d * bflo(g.x), bfhi(p.x) + d * bfhi(g.x)); o.y = pk2(bflo(p.y) + d * bflo(g.y), bfhi(p.y) + d * bfhi(g.y));
    o.z = pk2(bflo(p.z) + d * bflo(g.z), bfhi(p.z) + d * bfhi(g.z)); o.w = pk2(bflo(p.w) + d * bflo(g.w), bfhi(p.w) + d * bfhi(g.w)); return o; }
template <bool G8>
__device__ __forceinline__ void ml_m3(const Ctx& C, const bf16* QKC, const bf16* PROJ, const bf16* PL, const bf16* GS, const float* NLOC, const float* NSg, const float* MPREV, const float* DELTA,
                                      const float* gates, const float* head_gain, bf16* Gout) {
    LAS bf16* Qs = (LAS bf16*)(C.lds);
    LAS bf16* HB = (LAS bf16*)(C.lds + 17408);
    LAS bf16* Ks = HB;
    LAS bf16* Pm = (LAS bf16*)(C.lds + 51200);
    LAS bf16* Vn = (LAS bf16*)(C.lds + 60416);
    LAS bf16* Ct = (LAS bf16*)(C.lds + 77824);
    LAS float* aL = (LAS float*)(C.lds + 112640); LAS float* mxL = aL + 64; LAS float* winL = aL + 128; LAS float* rdenL = aL + 192; LAS float* emtL = aL + 256; LAS float* nprevL = aL + 320;
    const int r4 = C.tid >> 4, pc = C.tid & 15;
    v4u qk[4], vh0[2], ch0[4], gs0[4], vh1[2], ch1[4], gs1[4], og[4]; float ig_ = 0.f, lf_ = 0.f, mp_ = 0.f, np_ = 0.f, dl_ = 0.f;
#define M3_ISSUE_A(uu) do { const int bh_ = (uu) >> 6, c_ = (uu) & 63, b_ = bh_ >> 2, h_ = bh_ & 3; const int t0_ = b_ * SEQ + c_ * 64; \
        _Pragma("unroll") for (int i_ = 0; i_ < 4; ++i_) qk[i_] = *(const v4u*)(QKC + (size_t)(t0_ + r4 + 32 * (i_ & 1)) * 1024 + (i_ >> 1) * 512 + h_ * 128 + pc * 8); \
        _Pragma("unroll") for (int i_ = 0; i_ < 2; ++i_) vh0[i_] = *(const v4u*)(PROJ + (size_t)(t0_ + r4 + 32 * i_) * 3072 + 1024 + h_ * 256 + pc * 8); \
        const int gi_ = bh_ * 16 + (c_ >> 2); dl_ = DELTA[(uu)]; \
        _Pragma("unroll") for (int i_ = 0; i_ < 4; ++i_) { ch0[i_] = (c_ & 3) ? *(const v4u*)(PL + (size_t)(uu) * 32768 + (size_t)(r4 + 32 * i_) * 128 + pc * 8) : (v4u){0u, 0u, 0u, 0u};   gs0[i_] = *(const v4u*)(GS + (size_t)gi_ * 32768 + (size_t)(r4 + 32 * i_) * 128 + pc * 8); } \
        if (C.wave == 0) { ig_ = gates[(size_t)(t0_ + C.lane) * 8 + h_]; lf_ = gates[(size_t)(t0_ + C.lane) * 8 + 4 + h_]; mp_ = MPREV[(uu)]; } \
        if (C.tid >= 64 && C.tid < 192) np_ = NLOC[(size_t)(uu) * 128 + C.tid - 64] + dl_ * NSg[(size_t)gi_ * 128 + C.tid - 64]; } while (0)
    const int upw = 1024 / C.G;
    int u = C.blk * upw; const int uend = u + upw;
    M3_ISSUE_A(u);
    for (; u < uend; ++u) {
        const int bh = u >> 6, c = u & 63, b = bh >> 2, h = bh & 3; const int t0 = b * SEQ + c * 64;
#pragma unroll
        for (int i = 0; i < 4; ++i) *(LAS v4u*)(((i >> 1) ? Ks : Qs) + (r4 + 32 * (i & 1)) * 136 + pc * 8) = qk[i];
#pragma unroll
        for (int i = 0; i < 2; ++i) *(LAS v4u*)(Vn + (r4 + 32 * i) * 136 + pc * 8) = vh0[i];
        const float dl = dl_; const int gi = bh * 16 + (c >> 2);
#pragma unroll
        for (int i = 0; i < 4; ++i) *(LAS v4u*)(Ct + (r4 + 32 * i) * 136 + pc * 8) = comb8(ch0[i], gs0[i], dl);
        if (C.wave == 0) {
            const float bc = wave_incl_scan_add(lf_, C.lane); const float a = ig_ - bc; const float pm = wave_incl_scan_max(a, C.lane);
            const float mx = fmaxf(mp_, pm); const float mt = bc + mx;
            aL[C.lane] = a; mxL[C.lane] = mx; winL[C.lane] = __expf(mp_ - mx); emtL[C.lane] = __expf(-mt);
        }
        if (C.tid >= 64 && C.tid < 192) nprevL[C.tid - 64] = np_;
#pragma unroll
        for (int i = 0; i < 2; ++i) vh1[i] = *(const v4u*)(PROJ + (size_t)(t0 + r4 + 32 * i) * 3072 + 1024 + h * 256 + 128 + pc * 8);
#pragma unroll
        for (int i = 0; i < 4; ++i) { ch1[i] = (c & 3) ? *(const v4u*)(PL + (size_t)u * 32768 + (size_t)(128 + r4 + 32 * i) * 128 + pc * 8) : (v4u){0u, 0u, 0u, 0u}; gs1[i] = *(const v4u*)(GS + (size_t)gi * 32768 + (size_t)(128 + r4 + 32 * i) * 128 + pc * 8); }
        { const int row = C.tid >> 3, sub = C.tid & 7;
#pragma unroll
          for (int g8 = 0; g8 < 4; ++g8) og[g8] = *(const v4u*)(PROJ + (size_t)(t0 + row) * 3072 + 2048 + h * 256 + sub * 32 + g8 * 8); }
        __syncthreads();
        lds_mmx<64, 64, 128, false, false, 0, 4>(Ks, 136, Qs, 136, Ks, 136, Qs, 136, C.wave, C.lane, [=](int s0, int t, f32x4 v) {
            const float mxt = mxL[t]; f32x4 p;
#pragma unroll
            for (int j = 0; j < 4; ++j) p[j] = (s0 + j <= t) ? v[j] * __expf(aL[s0 + j] - mxt) : 0.f;
            *(LAS v2u*)(Pm + t * 72 + s0) = pack4(p); });
        __syncthreads();
        { const int t = C.tid >> 3, sub = C.tid & 7; float s1 = 0.f, s2 = 0.f;
          const v4u pr = *(const LAS v4u*)(Pm + t * 72 + sub * 8);
          s1 = (bflo(pr.x) + bfhi(pr.x)) + (bflo(pr.y) + bfhi(pr.y)) + (bflo(pr.z) + bfhi(pr.z)) + (bflo(pr.w) + bfhi(pr.w));
#pragma unroll
          for (int hh = 0; hh < 2; ++hh) { const v4u qr = *(const LAS v4u*)(Qs + t * 136 + sub * 16 + hh * 8); const LAS float* np = nprevL + sub * 16 + hh * 8;
              s2 += bflo(qr.x) * np[0] + bfhi(qr.x) * np[1] + bflo(qr.y) * np[2] + bfhi(qr.y) * np[3] + bflo(qr.z) * np[4] + bfhi(qr.z) * np[5] + bflo(qr.w) * np[6] + bfhi(qr.w) * np[7]; }
          s1 += __shfl_xor(s1, 1); s1 += __shfl_xor(s1, 2); s1 += __shfl_xor(s1, 4); s2 += __shfl_xor(s2, 1); s2 += __shfl_xor(s2, 2); s2 += __shfl_xor(s2, 4);
          if (sub == 0) { const float den = s1 + winL[t] * s2; rdenL[t] = __builtin_amdgcn_rcpf(fmaxf(fabsf(den), emtL[t])); } }
        __syncthreads();
        lds_mmx2<128, 64, 64, true, 128, 4>(Vn, 136, Pm, 72, Ct, 136, Qs, 136, C.wave, C.lane, [=](int dv0, int t, f32x4 v1, f32x4 v2) {
            *(LAS v2u*)(HB + t * 264 + dv0) = pack4((v1 + v2 * winL[t]) * rdenL[t]); });
        __syncthreads();
#pragma unroll
        for (int i = 0; i < 2; ++i) *(LAS v4u*)(Vn + (r4 + 32 * i) * 136 + pc * 8) = vh1[i];
#pragma unroll
        for (int i = 0; i < 4; ++i) *(LAS v4u*)(Ct + (r4 + 32 * i) * 136 + pc * 8) = comb8(ch1[i], gs1[i], dl);
        if (u + 1 < uend) M3_ISSUE_A(u + 1);
        __syncthreads();
        lds_mmx2<128, 64, 64, true, 128, 4>(Vn, 136, Pm, 72, Ct, 136, Qs, 136, C.wave, C.lane, [=](int dv0, int t, f32x4 v1, f32x4 v2) {
            *(LAS v2u*)(HB + t * 264 + 128 + dv0) = pack4((v1 + v2 * winL[t]) * rdenL[t]); });
        __syncthreads();
        { const int row = C.tid >> 3, sub = C.tid & 7; float ss = 0.f; v4u hr[4];
#pragma unroll
          for (int g8 = 0; g8 < 4; ++g8) { hr[g8] = *(const LAS v4u*)(HB + row * 264 + sub * 32 + g8 * 8);
              ss += bflo(hr[g8].x) * bflo(hr[g8].x) + bfhi(hr[g8].x) * bfhi(hr[g8].x) + bflo(hr[g8].y) * bflo(hr[g8].y) + bfhi(hr[g8].y) * bfhi(hr[g8].y)
                  + bflo(hr[g8].z) * bflo(hr[g8].z) + bfhi(hr[g8].z) * bfhi(hr[g8].z) + bflo(hr[g8].w) * bflo(hr[g8].w) + bfhi(hr[g8].w) * bfhi(hr[g8].w); }
          ss += __shfl_xor(ss, 1); ss += __shfl_xor(ss, 2); ss += __shfl_xor(ss, 4);
          const float inv = rsqrtf(ss * (1.f / 256.f) + EPS);
#pragma unroll
          for (int g8 = 0; g8 < 4; ++g8) { const int col = sub * 32 + g8 * 8; const v4u oraw = og[g8];
              const f32x4 g0 = *(const f32x4*)(head_gain + h * 256 + col), g1 = *(const f32x4*)(head_gain + h * 256 + col + 4);
              float hv[8];
              hv[0] = bflo(hr[g8].x) * inv * g0.x * sigmoidf_(bflo(oraw.x)); hv[1] = bfhi(hr[g8].x) * inv * g0.y * sigmoidf_(bfhi(oraw.x));
              hv[2] = bflo(hr[g8].y) * inv * g0.z * sigmoidf_(bflo(oraw.y)); hv[3] = bfhi(hr[g8].y) * inv * g0.w * sigmoidf_(bfhi(oraw.y));
              hv[4] = bflo(hr[g8].z) * inv * g1.x * sigmoidf_(bflo(oraw.z)); hv[5] = bfhi(hr[g8].z) * inv * g1.y * sigmoidf_(bfhi(oraw.z));
              hv[6] = bflo(hr[g8].w) * inv * g1.z * sigmoidf_(bflo(oraw.w)); hv[7] = bfhi(hr[g8].w) * inv * g1.w * sigmoidf_(bfhi(oraw.w));
              if constexpr (G8) { v2u o8; o8.x = pg8::cvt4_fp8(hv[0], hv[1], hv[2], hv[3]); o8.y = pg8::cvt4_fp8(hv[4], hv[5], hv[6], hv[7]);
                  *(v2u*)((unsigned char*)Gout + (size_t)(t0 + row) * 1024 + h * 256 + col) = o8; }
              else { v4u o; o.x = pk2(hv[0], hv[1]); o.y = pk2(hv[2], hv[3]); o.z = pk2(hv[4], hv[5]); o.w = pk2(hv[6], hv[7]);
                  *(v4u*)(Gout + (size_t)(t0 + row) * 1024 + h * 256 + col) = o; } } }
        __syncthreads();
    }
#undef M3_ISSUE_A
}

template <bool G8>
__device__ __forceinline__ void attn_phase(const Ctx& C, const bf16* QKV, const float* rel_bias, bf16* Gout) {
    LAS bf16* KV = (LAS bf16*)(C.lds);
    LAS float* bt = (LAS float*)(C.lds + 36864);
    const int r16 = C.lane & 15, g = C.lane >> 4, qt = (C.lane & 15) >> 2, pt = C.lane & 3;
    const int sr = C.tid >> 3, spc = C.tid & 7;
    for (int u = C.blk; u < 1024; u += C.G) {
        int bhh, cq;
        if (C.G == 256) { const int rnd = u >> 8, xcd = C.blk & 7, r = C.blk >> 3; bhh = rnd * 16 + xcd * 2 + (r >> 4); cq = r & 15; } else { bhh = u >> 4; cq = u & 15; }
        const int b = bhh >> 4, h = bhh & 15;
        const int myc = 4 * cq + (C.wave >> 1);
        const int qin = (C.wave & 1) * 32 + r16;
        const size_t qrow = (size_t)b * SEQ + myc * 64 + qin;
        bf16x8 qf[2][2];
#pragma unroll
        for (int q2 = 0; q2 < 2; ++q2) { qf[q2][0] = *(const bf16x8*)(QKV + (qrow + 16 * q2) * 3072 + h * 64 + 8 * g); qf[q2][1] = *(const bf16x8*)(QKV + (qrow + 16 * q2) * 3072 + h * 64 + 32 + 8 * g); }
        if (C.tid < 257) bt[C.tid] = (rel_bias[h * 257 + C.tid] - rel_bias[h * 257]) * 1.4426950408889634f;
        const int kc_lo = (4 * cq - 8) > 0 ? (4 * cq - 8) : 0, kc_hi = 4 * cq + 3, nt = kc_hi - kc_lo + 1;
        { const size_t krow = (size_t)b * SEQ + kc_lo * 64 + sr;
          const v4u kr0 = *(const v4u*)(QKV + krow * 3072 + 1024 + h * 64 + spc * 8), vr0 = *(const v4u*)(QKV + krow * 3072 + 2048 + h * 64 + spc * 8);
          *(LAS v4u*)(KV + sr * 72 + spc * 8) = kr0; *(LAS v4u*)(KV + 4608 + sr * 72 + spc * 8) = vr0; }
        v4u kr = {0u, 0u, 0u, 0u}, vr = {0u, 0u, 0u, 0u};
        if (nt > 1) { const size_t krow = (size_t)b * SEQ + (kc_lo + 1) * 64 + sr;
            kr = *(const v4u*)(QKV + krow * 3072 + 1024 + h * 64 + spc * 8); vr = *(const v4u*)(QKV + krow * 3072 + 2048 + h * 64 + spc * 8); }
        __syncthreads();
        float m[2] = {-1e30f, -1e30f}; f32x4 O[2][4], L[2] = {{0.f, 0.f, 0.f, 0.f}, {0.f, 0.f, 0.f, 0.f}};
        const bf16x8 ones = {0x3F80, 0x3F80, 0x3F80, 0x3F80, 0x3F80, 0x3F80, 0x3F80, 0x3F80};
#pragma unroll
        for (int q2 = 0; q2 < 2; ++q2)
#pragma unroll
            for (int d = 0; d < 4; ++d) O[q2][d] = (f32x4){0.f, 0.f, 0.f, 0.f};
        for (int j = 0; j < nt; ++j) {
            const int kc = kc_lo + j; const bool more = (j + 1 < nt);
            v4u kr2 = {0u, 0u, 0u, 0u}, vr2 = {0u, 0u, 0u, 0u};
            if (j + 2 < nt) { const size_t krow = (size_t)b * SEQ + (kc + 2) * 64 + sr;
                kr2 = *(const v4u*)(QKV + krow * 3072 + 1024 + h * 64 + spc * 8); vr2 = *(const v4u*)(QKV + krow * 3072 + 2048 + h * 64 + spc * 8); }
            if (kc >= myc - 8 && kc <= myc) {
                const LAS bf16* Kb = KV + (j & 1) * 9216; const LAS bf16* Vb = Kb + 4608;
                f32x4 S[2][4];
#pragma unroll
                for (int kt = 0; kt < 4; ++kt) { S[0][kt] = (f32x4){0.f, 0.f, 0.f, 0.f}; S[1][kt] = (f32x4){0.f, 0.f, 0.f, 0.f};
#pragma unroll
                    for (int kk = 0; kk < 2; ++kk) { const bf16x8 kf = *(const LAS bf16x8*)(Kb + (16 * kt + r16) * 72 + 32 * kk + 8 * g);
                        S[0][kt] = __builtin_amdgcn_mfma_f32_16x16x32_bf16(kf, qf[0][kk], S[0][kt], 0, 0, 0);
                        S[1][kt] = __builtin_amdgcn_mfma_f32_16x16x32_bf16(kf, qf[1][kk], S[1][kt], 0, 0, 0); } }
                bf16x8 pf[2][2];
#pragma unroll
                for (int q2 = 0; q2 < 2; ++q2) {
                    if (kc >= myc - 2) { const int relb = (kc - myc) * 64 - (qin + 16 * q2) + 4 * g + 128;
#pragma unroll
                        for (int kt = 0; kt < 4; ++kt)
#pragma unroll
                            for (int jj = 0; jj < 4; ++jj) { int idx = relb + 16 * kt + jj; idx = idx < 0 ? 0 : (idx > 256 ? 256 : idx); S[q2][kt][jj] += bt[idx]; }
                    }
                    float tm = fmaxf(fmaxf(S[q2][0][0], S[q2][0][1]), fmaxf(S[q2][0][2], S[q2][0][3]));
#pragma unroll
                    for (int kt = 1; kt < 4; ++kt) tm = fmaxf(tm, fmaxf(fmaxf(S[q2][kt][0], S[q2][kt][1]), fmaxf(S[q2][kt][2], S[q2][kt][3])));
                    tm = fmaxf(tm, __shfl_xor(tm, 16)); tm = fmaxf(tm, __shfl_xor(tm, 32));
                    const float mn = fmaxf(m[q2], tm); const float alpha = __builtin_amdgcn_exp2f(m[q2] - mn); m[q2] = mn;
#pragma unroll
                    for (int kt = 0; kt < 4; ++kt)
#pragma unroll
                        for (int jj = 0; jj < 4; ++jj) S[q2][kt][jj] = __builtin_amdgcn_exp2f(S[q2][kt][jj] - mn);
                    L[q2] *= alpha;
#pragma unroll
                    for (int d = 0; d < 4; ++d) O[q2][d] *= alpha;
#pragma unroll
                    for (int ks = 0; ks < 2; ++ks) { v4u w; w.x = pk2(S[q2][2 * ks][0], S[q2][2 * ks][1]); w.y = pk2(S[q2][2 * ks][2], S[q2][2 * ks][3]);
                        w.z = pk2(S[q2][2 * ks + 1][0], S[q2][2 * ks + 1][1]); w.w = pk2(S[q2][2 * ks + 1][2], S[q2][2 * ks + 1][3]); pf[q2][ks] = __builtin_bit_cast(bf16x8, w); }
                }
#pragma unroll
                for (int d = 0; d < 4; ++d)
#pragma unroll
                    for (int ks = 0; ks < 2; ++ks) { const s16x4 v0 = lds_tr16(Vb + (32 * ks + 4 * g + qt) * 72 + 16 * d + 4 * pt), v1 = lds_tr16(Vb + (32 * ks + 16 + 4 * g + qt) * 72 + 16 * d + 4 * pt);
                        const bf16x8 vf = {v0[0], v0[1], v0[2], v0[3], v1[0], v1[1], v1[2], v1[3]};
                        O[0][d] = __builtin_amdgcn_mfma_f32_16x16x32_bf16(vf, pf[0][ks], O[0][d], 0, 0, 0);
                        O[1][d] = __builtin_amdgcn_mfma_f32_16x16x32_bf16(vf, pf[1][ks], O[1][d], 0, 0, 0); }
#pragma unroll
                for (int ks = 0; ks < 2; ++ks) { L[0] = __builtin_amdgcn_mfma_f32_16x16x32_bf16(ones, pf[0][ks], L[0], 0, 0, 0); L[1] = __builtin_amdgcn_mfma_f32_16x16x32_bf16(ones, pf[1][ks], L[1], 0, 0, 0); }
            }
            if (more) { LAS bf16* Kn = KV + ((j + 1) & 1) * 9216; *(LAS v4u*)(Kn + sr * 72 + spc * 8) = kr; *(LAS v4u*)(Kn + 4608 + sr * 72 + spc * 8) = vr; }
            kr = kr2; vr = vr2;
            __syncthreads();
        }
#pragma unroll
        for (int q2 = 0; q2 < 2; ++q2) { const float il = __builtin_amdgcn_rcpf(L[q2][0]);
#pragma unroll
            for (int d = 0; d < 4; ++d) { const f32x4 o = O[q2][d] * il;
                if constexpr (G8) *(unsigned*)((unsigned char*)Gout + (qrow + 16 * q2) * 1024 + h * 64 + 16 * d + 4 * g) = pg8::cvt4_fp8(o[0], o[1], o[2], o[3]);
                else { v2u w; w.x = pk2(o[0], o[1]); w.y = pk2(o[2], o[3]); *(v2u*)(Gout + (qrow + 16 * q2) * 1024 + h * 64 + 16 * d + 4 * g) = w; } } }
        __syncthreads();
    }
}

__device__ __forceinline__ float gelu_tanh(float y) { return y * sigmoidf_(1.5957691216057308f * (y + 0.044715f * y * y * y)); }
__device__ __forceinline__ void s5_phase(const Ctx& C, const float* U32, const float* lam_re, const float* lam_im, const float* log_dt, const float* b_re, const float* b_im,
                                         const float* c_re, const float* c_im, const float* dskip, bf16* YG) {
    LAS bf16* BuT = (LAS bf16*)(C.lds);
    LAS bf16* Ub = (LAS bf16*)(C.lds + 67584);
    LAS float* uL = (LAS float*)(C.lds + 88064);
    LAS bf16* BBm = (LAS bf16*)(C.lds + 104448);
    LAS bf16* Cm = (LAS bf16*)(C.lds + 114688);
    LAS float* xend = (LAS float*)(C.lds + 119040);
    for (int u = C.blk; u < 256; u += C.G) {
        const int g = u >> 2, b = u & 3; const int n = C.lane;
        const float lr = lam_re[g * 64 + n], li = lam_im[g * 64 + n], dt = expf(log_dt[g]);
        const float mag = expf(lr * dt), ang = li * dt; const float ar = mag * cosf(ang), ai = mag * sinf(ang);
        const float mag32 = expf(32.f * lr * dt), ang32 = 32.f * ang; const float a32r = mag32 * cosf(ang32), a32i = mag32 * sinf(ang32);
        if (C.wave == 0) {
            const float den = lr * lr + li * li, nr = ar - 1.0f; const float zr = (nr * lr + ai * li) / den, zi = (ai * lr - nr * li) / den;
#pragma unroll
            for (int q = 0; q < 16; ++q) { const float br = b_re[(size_t)(g * 64 + n) * 16 + q], bi = b_im[(size_t)(g * 64 + n) * 16 + q];
                BBm[n * 40 + q] = (bf16)f2bf(zr * br - zi * bi); BBm[(64 + n) * 40 + q] = (bf16)f2bf(zr * bi + zi * br); }
        }
        for (int idx = C.tid; idx < 128 * 16; idx += NTHR) BBm[(idx >> 4) * 40 + 16 + (idx & 15)] = 0;
        for (int idx = C.tid; idx < 256 * 16; idx += NTHR) Ub[(idx >> 4) * 40 + 16 + (idx & 15)] = 0;
        for (int idx = C.tid; idx < 1024; idx += NTHR) { const int p = idx >> 6, nn = idx & 63;
            Cm[p * 136 + nn] = (bf16)f2bf(c_re[(size_t)(g * 16 + p) * 64 + nn]); Cm[p * 136 + 64 + nn] = (bf16)f2bf(-c_im[(size_t)(g * 16 + p) * 64 + nn]); }
        const int sr = C.tid >> 1, sq0 = (C.tid & 1) * 8;
        const float* ubase = U32 + ((size_t)g * T + (size_t)b * SEQ + sr) * 16 + sq0;
        f32x4 un0 = *(const f32x4*)ubase, un1 = *(const f32x4*)(ubase + 4);
        f32x4 um0 = *(const f32x4*)(ubase + 256 * 16), um1 = *(const f32x4*)(ubase + 256 * 16 + 4);
        float cr = 0.f, ci = 0.f;
        const f32x4 dvq = *(const f32x4*)(dskip + g * 16 + 4 * (C.lane >> 4));
        LAS v4u* myre = (LAS v4u*)(BuT + n * 264 + C.wave * 32); LAS v4u* myim = (LAS v4u*)(BuT + (64 + n) * 264 + C.wave * 32);
        for (int it = 0; it < 16; ++it) {
            const int tb = it * 256;
            *(LAS f32x4*)(uL + sr * 16 + sq0) = un0; *(LAS f32x4*)(uL + sr * 16 + sq0 + 4) = un1;
            { v4u w; w.x = pk2(un0.x, un0.y); w.y = pk2(un0.z, un0.w); w.z = pk2(un1.x, un1.y); w.w = pk2(un1.z, un1.w); *(LAS v4u*)(Ub + sr * 40 + sq0) = w; }
            un0 = um0; un1 = um1;
            if (it + 2 < 16) { const float* src = ubase + (size_t)(tb + 512) * 16; um0 = *(const f32x4*)src; um1 = *(const f32x4*)(src + 4); }
            __syncthreads();
            lds_mmx<256, 128, 32, false, false, 0, 4>(Ub, 40, BBm, 40, Ub, 40, BBm, 40, C.wave, C.lane, [=](int tok0, int st, f32x4 v) { *(LAS v2u*)(BuT + st * 264 + tok0) = pack4(v); });
            __syncthreads();
            v4u br[4], bi[4];
#pragma unroll
            for (int k = 0; k < 4; ++k) { br[k] = myre[k]; bi[k] = myim[k]; }
            float xr = 0.f, xi = 0.f;
#pragma unroll
            for (int k = 0; k < 4; ++k)
#pragma unroll
                for (int e = 0; e < 4; ++e) { const unsigned wr_ = br[k][e], wi_ = bi[k][e];
                    float nxr = ar * xr - ai * xi + bflo(wr_), nxi = ar * xi + ai * xr + bflo(wi_); xr = nxr; xi = nxi;
                    nxr = ar * xr - ai * xi + bfhi(wr_); nxi = ar * xi + ai * xr + bfhi(wi_); xr = nxr; xi = nxi; }
            xend[(C.wave * 64 + n) * 2] = xr; xend[(C.wave * 64 + n) * 2 + 1] = xi;
            __syncthreads();
            float Xr = cr, Xi = ci, myr = 0.f, myi = 0.f;
#pragma unroll
            for (int w = 0; w < 8; ++w) { if (w == C.wave) { myr = Xr; myi = Xi; }
                const float er = xend[(w * 64 + n) * 2], ei = xend[(w * 64 + n) * 2 + 1];
                const float nXr = a32r * Xr - a32i * Xi + er, nXi = a32r * Xi + a32i * Xr + ei; Xr = nXr; Xi = nXi; }
            cr = Xr; ci = Xi;
            xr = myr; xi = myi;
#pragma unroll
            for (int k = 0; k < 4; ++k) {
#pragma unroll
                for (int e = 0; e < 4; ++e) { const unsigned wr_ = br[k][e], wi_ = bi[k][e];
                    float nxr = ar * xr - ai * xi + bflo(wr_), nxi = ar * xi + ai * xr + bflo(wi_); xr = nxr; xi = nxi; const float r0 = xr, i0 = xi;
                    nxr = ar * xr - ai * xi + bfhi(wr_); nxi = ar * xi + ai * xr + bfhi(wi_); xr = nxr; xi = nxi;
                    br[k][e] = pk2(r0, xr); bi[k][e] = pk2(i0, xi); }
                myre[k] = br[k]; myim[k] = bi[k]; }
            __syncthreads();
            const int trow0 = b * SEQ + tb;
            lds_mmx<16, 256, 128, false, true, 0, 2>(Cm, 136, BuT, 264, Cm, 136, BuT, 264, C.wave, C.lane, [=](int p0, int tok, f32x4 v) {
                const f32x4 dv = dvq; const f32x4 uv = *(const LAS f32x4*)(uL + tok * 16 + p0);
                const f32x4 y = v + dv * uv;
#if S5_FP8
                *(unsigned*)((unsigned char*)YG + ((size_t)g * T + trow0 + tok) * 16 + p0) = pg8::cvt4_fp8(gelu_tanh(y.x), gelu_tanh(y.y), gelu_tanh(y.z), gelu_tanh(y.w));
#else
                v2u w; w.x = pk2(gelu_tanh(y.x), gelu_tanh(y.y)); w.y = pk2(gelu_tanh(y.z), gelu_tanh(y.w));
                *(v2u*)(YG + (size_t)(trow0 + tok) * D + g * 16 + p0) = w;
#endif
                });
            __syncthreads();
        }
    }
}

__device__ __forceinline__ void moe_r1(const Ctx& C, const bf16* X, const float* gain, const float* router, const float* rb, bf16* XN, int* TE, float* TW, int* CNT) {
    LAS int* cnt = (LAS int*)(C.lds + 32768);
    f32x4 wg[32];
    load_w8(C, router, 8, wg);
    float rbv[8];
#pragma unroll
    for (int e = 0; e < 8; ++e) rbv[e] = rb[e];
    if (C.tid < 8) cnt[C.tid] = 0;
    __syncthreads();
    f32x4 g[4];
#pragma unroll
    for (int j = 0; j < 4; ++j) g[j] = ((const f32x4*)gain)[C.lane + 64 * j];
    f32x4 nx[4];
    {
#pragma unroll
      for (int j = 0; j < 4; ++j) nx[j] = ldx4(X + (size_t)(C.blk * 64 + C.wave * 8) * D, C.lane + 64 * j); }
    for (int i = 0; i < 8; ++i) {
        const int m = C.blk * 64 + C.wave * 8 + i;
        f32x4 v[4]; float ss = 0.f;
#pragma unroll
        for (int j = 0; j < 4; ++j) v[j] = nx[j];
        if (i + 1 < 8) {
#pragma unroll
            for (int j = 0; j < 4; ++j) nx[j] = ldx4(X + (size_t)(m + 1) * D, C.lane + 64 * j); }
#pragma unroll
        for (int j = 0; j < 4; ++j) ss += (v[j].x * v[j].x + v[j].y * v[j].y) + (v[j].z * v[j].z + v[j].w * v[j].w);
        const float inv = rsqrtf(wave_sum(ss) * (1.f / D) + EPS);
        unsigned* o4 = (unsigned*)((unsigned char*)XN + (size_t)m * D) + C.lane;
#pragma unroll
        for (int j = 0; j < 4; ++j) { v[j] = v[j] * inv * g[j]; o4[64 * j] = pg8::cvt4_fp8(v[j].x, v[j].y, v[j].z, v[j].w); }
        float p[8];
#pragma unroll
        for (int e = 0; e < 8; ++e) p[e] = 0.f;
#pragma unroll
        for (int j = 0; j < 4; ++j)
#pragma unroll
            for (int c = 0; c < 4; ++c) { const f32x4 w0 = wg[(4 * j + c) * 2], w1 = wg[(4 * j + c) * 2 + 1]; const float h = v[j][c];
                p[0] += h * w0.x; p[1] += h * w0.y; p[2] += h * w0.z; p[3] += h * w0.w; p[4] += h * w1.x; p[5] += h * w1.y; p[6] += h * w1.z; p[7] += h * w1.w; }
        { const float tot = wave_sum8(p, C.lane);
#pragma unroll
          for (int e = 0; e < 8; ++e) p[e] = __shfl(tot, (e >> 2) | (((e >> 1) & 1) << 1) | ((e & 1) << 2)) + rbv[e]; }
        int e1 = 0; float v1 = p[0];
#pragma unroll
        for (int e = 1; e < 8; ++e) if (p[e] > v1) { v1 = p[e]; e1 = e; }
        int e2 = -1; float v2 = -3.0e38f;
#pragma unroll
        for (int e = 0; e < 8; ++e) if (e != e1 && p[e] > v2) { v2 = p[e]; e2 = e; }
        const float w1 = 1.0f / (1.0f + __expf(v2 - v1)), w2 = 1.0f - w1;
        if (C.lane == 0) { TE[m] = e1 | (e2 << 8); TW[2 * m] = w1; TW[2 * m + 1] = w2; atomicAdd((int*)&cnt[e1], 1); atomicAdd((int*)&cnt[e2], 1); }
    }
    __syncthreads();
    if (C.tid < 8) CNT[C.blk * 8 + C.tid] = cnt[C.tid];
    __syncthreads();
}
__device__ __forceinline__ void moe_r2(const Ctx& C, const bf16* XN, const int* TE, const float* TW, const int* CNT, int* SLOT, float* GW, int* PANEL_E, unsigned char* XG8) {
    LAS int* tot = (LAS int*)(C.lds); LAS int* pre = tot + 8; LAS int* base = tot + 16; LAS int* slotL = tot + 32;
    if (C.tid < 16) tot[C.tid] = 0;
    __syncthreads();
    for (int q = C.tid; q < C.G * 2; q += NTHR) { const int bb = q >> 1, e0 = (q & 1) * 4; const v4u c = *(const v4u*)(CNT + bb * 8 + e0);
        atomicAdd((int*)&tot[e0], (int)c.x); atomicAdd((int*)&tot[e0 + 1], (int)c.y); atomicAdd((int*)&tot[e0 + 2], (int)c.z); atomicAdd((int*)&tot[e0 + 3], (int)c.w);
        if (bb < C.blk) { atomicAdd((int*)&pre[e0], (int)c.x); atomicAdd((int*)&pre[e0 + 1], (int)c.y); atomicAdd((int*)&pre[e0 + 2], (int)c.z); atomicAdd((int*)&pre[e0 + 3], (int)c.w); } }
    __syncthreads();
    if (C.tid == 0) { int acc = 0; for (int e = 0; e < 8; ++e) { base[e] = acc; acc += (tot[e] + 255) & ~255; } base[8] = acc;
        if (C.blk == 0) { for (int e = 0; e < 8; ++e) for (int p = base[e] >> 8; p < (base[e + 1] >> 8); ++p) PANEL_E[p] = e; PANEL_E[MAXPANEL] = acc >> 8; } }
    __syncthreads();
    if (C.wave == 0) {
        const int t = C.blk * 64 + C.lane; const int te = TE[t]; const int e1 = te & 255, e2 = te >> 8; int s1 = 0, s2 = 0;
        const unsigned long long below = (C.lane == 0) ? 0ull : (~0ull >> (64 - C.lane));
#pragma unroll
        for (int e = 0; e < 8; ++e) { const unsigned long long mem = __ballot(e1 == e || e2 == e); const int pos = base[e] + pre[e] + __popcll(mem & below);
            if (e1 == e) s1 = pos; if (e2 == e) s2 = pos; }
        SLOT[2 * t] = s1; SLOT[2 * t + 1] = s2; GW[s1] = TW[2 * t]; GW[s2] = TW[2 * t + 1]; slotL[2 * C.lane] = s1; slotL[2 * C.lane + 1] = s2;
    }
    __syncthreads();
    for (int r0 = C.wave * 16; r0 < C.wave * 16 + 16; r0 += 8) { v4u a[4];
#pragma unroll
        for (int k = 0; k < 4; ++k) { const int t = C.blk * 64 + ((r0 + 2 * k) >> 1); a[k] = ((const v4u*)((const unsigned char*)XN + (size_t)t * D))[C.lane]; }
#pragma unroll
        for (int k = 0; k < 4; ++k) { *((v4u*)(XG8 + (size_t)slotL[r0 + 2 * k] * D) + C.lane) = a[k]; *((v4u*)(XG8 + (size_t)slotL[r0 + 2 * k + 1] * D) + C.lane) = a[k]; } }
    const int gw = C.blk * NWAVES + C.wave, NGW = C.G * NWAVES;
    for (int e = 0; e < 8; ++e) { const int t = tot[e]; const int npad = ((t + 255) & ~255) - t;
        for (int k = gw; k < npad; k += NGW) { const int row = base[e] + t + k; v4u* d = (v4u*)(XG8 + (size_t)row * D); const v4u z = {0u, 0u, 0u, 0u}; d[C.lane] = z; if (C.lane == 0) GW[row] = 0.f; } }
    __syncthreads();
}
template <bool FINAL, bool XN8 = false>
__device__ __forceinline__ void combine_phase(const Ctx& C, bf16* X, const bf16* Y, const int* SLOT, const float* gain, bf16* XN, float* out) {
    const int gw = C.blk * NWAVES + C.wave, NGW = C.G * NWAVES;
    f32x4 g[4];
#pragma unroll
    for (int j = 0; j < 4; ++j) g[j] = ((const f32x4*)gain)[C.lane + 64 * j];
    f32x4 nx[4]; v2u na[4], nb[4];
    if (gw < T) { const int s1 = SLOT[2 * gw], s2 = SLOT[2 * gw + 1];
        const v2u* y1 = (const v2u*)(Y + (size_t)s1 * D) + C.lane; const v2u* y2 = (const v2u*)(Y + (size_t)s2 * D) + C.lane;
#pragma unroll
        for (int j = 0; j < 4; ++j) { nx[j] = ldx4(X + (size_t)gw * D, C.lane + 64 * j); na[j] = y1[64 * j]; nb[j] = y2[64 * j]; } }
    int ns1 = 0, ns2 = 0;
    if (gw + NGW < T) { ns1 = SLOT[2 * (gw + NGW)]; ns2 = SLOT[2 * (gw + NGW) + 1]; }
    for (int m = gw; m < T; m += NGW) {
        f32x4 v[4]; v2u a[4], b[4]; float ss = 0.f;
#pragma unroll
        for (int j = 0; j < 4; ++j) { v[j] = nx[j]; a[j] = na[j]; b[j] = nb[j]; }
        if (m + NGW < T) {
            const v2u* y1 = (const v2u*)(Y + (size_t)ns1 * D) + C.lane; const v2u* y2 = (const v2u*)(Y + (size_t)ns2 * D) + C.lane;
#pragma unroll
            for (int j = 0; j < 4; ++j) { nx[j] = ldx4(X + (size_t)(m + NGW) * D, C.lane + 64 * j); na[j] = y1[64 * j]; nb[j] = y2[64 * j]; }
            if (m + 2 * NGW < T) { ns1 = SLOT[2 * (m + 2 * NGW)]; ns2 = SLOT[2 * (m + 2 * NGW) + 1]; } }
#pragma unroll
        for (int j = 0; j < 4; ++j) {
            v[j].x += bflo(a[j].x) + bflo(b[j].x); v[j].y += bfhi(a[j].x) + bfhi(b[j].x); v[j].z += bflo(a[j].y) + bflo(b[j].y); v[j].w += bfhi(a[j].y) + bfhi(b[j].y);
            ss += (v[j].x * v[j].x + v[j].y * v[j].y) + (v[j].z * v[j].z + v[j].w * v[j].w); }
        const float inv = rsqrtf(wave_sum(ss) * (1.f / D) + EPS);
        if constexpr (FINAL) { f32x4* o = (f32x4*)(out + (size_t)m * D) + C.lane;
#pragma unroll
            for (int j = 0; j < 4; ++j) o[64 * j] = v[j] * inv * g[j];
        } else { v2u* xw = (v2u*)(X + (size_t)m * D) + C.lane; unsigned long long* o8 = (unsigned long long*)(XN + (size_t)m * D) + C.lane;
#pragma unroll
            for (int j = 0; j < 4; ++j) { v2u xo; xo.x = pk2(v[j].x, v[j].y); xo.y = pk2(v[j].z, v[j].w); xw[64 * j] = xo; const f32x4 hn = v[j] * inv * g[j];
                if constexpr (XN8) ((unsigned*)((unsigned char*)XN + (size_t)m * D) + C.lane)[64 * j] = pg8::cvt4_fp8(hn.x, hn.y, hn.z, hn.w);
                else o8[64 * j] = (unsigned long long)pk2(hn.x, hn.y) | ((unsigned long long)pk2(hn.z, hn.w) << 32); } }
    }
}

struct Args { const float* in[30]; float* out; unsigned char* ws; int ph_lo, ph_hi, li, pad; };
constexpr int NPHASES = 35;

__global__ void __launch_bounds__(NTHR, 2) fwd_kernel(Args args) {
    extern __shared__ __attribute__((aligned(16))) unsigned char lds_raw[];
    Ctx C; C.lds = (LAS unsigned char*)lds_raw; C.wave = __builtin_amdgcn_readfirstlane(threadIdx.x >> 6); C.lane = pg8::lane_asm(); C.tid = C.wave * 64 + C.lane; C.blk = blockIdx.x; C.G = gridDim.x;
#define REFRESH() do { C.lane = pg8::lane_asm(); C.tid = C.wave * 64 + C.lane; } while (0)
    volatile LAS unsigned* MISC = (volatile LAS unsigned*)(C.lds + MISC_OFF);
    unsigned char* ws = args.ws;
    unsigned* ctl = (unsigned*)(ws + WS_CTL);
    for (int u = C.tid; u < (LDS_BYTES - RING_BYTES) / 4; u += NTHR) ((LAS unsigned*)(C.lds + RING_BYTES))[u] = 0u;
    __syncthreads();
#if MK_PER_PHASE
#define GRID_BAR() do { } while (0)
#else
    XcdBarrier bar = xcd_barrier_post(ctl + CW_BAR, MISC + 8, C.wave);
#define GRID_BAR() xcd_barrier(bar)
#endif
    const int lo = args.ph_lo, hi = args.ph_hi;
#define IN_(k) (lo <= (k) && (k) < hi)
#define IN(k) (IN_(k) && (C.lane = pg8::lane_asm(), C.tid = C.wave * 64 + C.lane, true))
#define SEAM(k) do { if (IN_(k) && IN_((k) + 1)) { GRID_BAR(); } } while (0)
    const float* const* in = args.in;
    const float* x_in = in[0];
    bf16* X = (bf16*)(ws + WS_X); unsigned char* X8 = ws + WS_X8; float* SSQA = (float*)(ws + WS_SSQ); float* SSQB = (float*)(ws + WS_SSQ + 2 * MiB); float* SSQC = (float*)(ws + WS_SSQ + 4 * MiB); bf16* XN = (bf16*)(ws + WS_XN);
    bf16* PROJ = (bf16*)(ws + WS_PROJ); bf16* QKC = (bf16*)(ws + WS_QKC); bf16* UC = (bf16*)(ws + WS_UC); bf16* CS = (bf16*)(ws + WS_CS); bf16* Gb = (bf16*)(ws + WS_G);
    bf16* Hb = (bf16*)(ws + WS_H); unsigned char* H8 = ws + WS_H; unsigned char* XG8 = ws + WS_XG; bf16* Yb = (bf16*)(ws + WS_Y); float* U32 = (float*)(ws + WS_U32);
    LAS unsigned char* ring = C.lds;

#define GEMM_DENSE(EPI, Aptr, Bptr, NN, KK, EOBJ) do { pg8::Gemm g_{(const pg8::bf16_t*)(Aptr), (const pg8::bf16_t*)(Bptr), T, (NN), (KK), 0, C.wave}; pg8::StaticOrder S_; S_.init(T, (NN), C.G, C.blk); \
        pg8::gemm_phase<EPI, pg8::StaticOrder, true, true>(ring, g_, S_, EOBJ); } while (0)

#define ML_LAYER(P0, J, LAYER, XSRC, XBF_) do { \
    float* gates_ = (float*)(ws + TAB_GATES + (J) * 524288); float* BC_ = (float*)(ws + TAB_BC + (J) * 4096); float* PC_ = (float*)(ws + TAB_PC + (J) * 4096); float* MP_ = (float*)(ws + TAB_MPREV + (J) * 4096); \
    float* NU_ = (float*)(ws + TAB_NU + (J) * 524288); float* NS_ = (float*)(ws + TAB_NS + (J) * 524288); \
    if (IN((P0))) { norm_phase<true, (XBF_), XBF_>(C, (XSRC), in[1] + (LAYER) * D, XN, in[4] + (size_t)(J) * D * 3080, in[5] + (J) * 8, gates_); } SEAM((P0)); \
    if (IN((P0) + 1)) { if constexpr (XBF_) {   \
            pg8::Gemm g_{(const pg8::bf16_t*)XN, (const pg8::bf16_t*)(ws + W_ML_IN + (J) * SZ_ML_IN), T, 3072, D / 2, 0, C.wave}; pg8::StaticOrder S_; S_.init(T, 3072, C.G, C.blk); \
            pg8::EpiBf16<0> E_{(pg8::bf16_t*)PROJ, 3072, 3072, 0.015625f, nullptr}; pg8::gemm_phase<pg8::EpiBf16<0>, pg8::StaticOrder, true, true, true>(ring, g_, S_, E_); \
        } else { pg8::EpiBf16<0> E_{(pg8::bf16_t*)PROJ, 3072, 0, 1.f, nullptr}; GEMM_DENSE(pg8::EpiBf16<0>, XN, ws + W_ML_IN + (J) * SZ_ML_IN, 3072, D, E_); } } SEAM((P0) + 1); \
    bf16* GT_ = CS; bf16* GS_ = CS + (size_t)8 * MiB; float* NT_ = NS_; float* NSg_ = NS_ + 65536;     \
    if (IN((P0) + 2)) { ml_m1(C, PROJ, gates_, in[6] + (J) * 4096, QKC, UC, GT_, NU_, NT_, MP_, BC_, PC_); } SEAM((P0) + 2); \
    if (IN((P0) + 3)) { ml_m2(C, GT_, GS_, NT_, NSg_, PC_); } SEAM((P0) + 3); \
    if (IN((P0) + 4)) { ml_m3<(XBF_)>(C, QKC, PROJ, UC, GS_, NU_, NSg_, MP_, BC_, gates_, in[7] + (J) * D, Gb); } SEAM((P0) + 4); \
    if (IN((P0) + 5)) { using ER_ = pg8::EpiRes<!(XBF_), !(XBF_)>; \
        if constexpr (XBF_) { pg8::Gemm g_{(const pg8::bf16_t*)Gb, (const pg8::bf16_t*)(ws + W_ML_OUT + (J) * SZ_ML_OUT), T, D, D / 2, 0, C.wave}; pg8::StaticOrder S_; S_.init(T, D, C.G, C.blk); \
            ER_ E_{(XSRC), (pg8::bf16_t*)X, D, 0.015625f, SSQA}; pg8::gemm_phase<ER_, pg8::StaticOrder, true, true, true>(ring, g_, S_, E_); } \
        else { ER_ E_{(XSRC), (pg8::bf16_t*)X, D, 1.f, SSQA}; GEMM_DENSE(ER_, Gb, ws + W_ML_OUT + (J) * SZ_ML_OUT, D, D, E_); } } SEAM((P0) + 5); \
  } while (0)
#define DENSE_FFN(P0, F, LAYER) do { \
      \
    if (IN((P0) + 1)) { pg8::EpiSwiGLU<16> E_{(pg8::bf16_t*)Hb, FFD, SSQA}; GEMM_DENSE(pg8::EpiSwiGLU<16>, X, ws + W_FF_GU + (F) * SZ_FF_GU, 2 * FFD, D, E_); \
        if ((F) == 0 && C.blk >= 128) { REFRESH(); convert_phase(C, in, ws, 1, (C.blk - 128) * NWAVES + C.wave, 128 * NWAVES); } } SEAM((P0) + 1); \
    if (IN((P0) + 2)) { using ER_ = pg8::EpiRes<false, true, (AT_FP8 != 0)>; ER_ E_{X, (pg8::bf16_t*)X, D, 1.f, SSQB, X8}; GEMM_DENSE(ER_, Hb, ws + W_FF_D + (F) * SZ_FF_D, D, FFD, E_); } SEAM((P0) + 2); \
  } while (0)
#define DENSE_FFN8(P0, F, LAYER) do { \
      \
    if (IN((P0) + 1)) { pg8::Gemm g_{(const pg8::bf16_t*)X8, (const pg8::bf16_t*)(ws + W_FF_GU + (F) * SZ_FF_GU), T, 2 * FFD, D / 2, 0, C.wave}; pg8::StaticOrder S_; S_.init(T, 2 * FFD, C.G, C.blk); \
        pg8::EpiSwiGLU8<32> E_{H8, FFD, 0.015625f, 8.f, SSQC}; pg8::gemm_phase<pg8::EpiSwiGLU8<32>, pg8::StaticOrder, true, true, true>(ring, g_, S_, E_); \
        if (C.blk >= 128) { REFRESH(); convert_phase(C, in, ws, 3, (C.blk - 128) * NWAVES + C.wave, 128 * NWAVES); } } SEAM((P0) + 1); \
    if (IN((P0) + 2)) { pg8::Gemm g_{(const pg8::bf16_t*)H8, (const pg8::bf16_t*)(ws + W_FF_D + (F) * SZ_FF_D), T, D, FFD / 2, 0, C.wave}; pg8::StaticOrder S_; S_.init(T, D, C.G, C.blk); \
        pg8::EpiRes<false> E_{X, (pg8::bf16_t*)X, D, 0.001953125f, nullptr}; pg8::gemm_phase<pg8::EpiRes<false>, pg8::StaticOrder, true, true, true>(ring, g_, S_, E_); } SEAM((P0) + 2); \
  } while (0)
#define MOE_FFN(P0, F, LAYER, FINAL, NEXTGAIN) do { \
    unsigned char* mt_ = ws + TAB_MOE + (F) * MiB; int* TE_ = (int*)(mt_ + MOE_TE); float* TW_ = (float*)(mt_ + MOE_TW); int* SLOT_ = (int*)(mt_ + MOE_SLOT); float* GW_ = (float*)(mt_ + MOE_GW); \
    int* CNT_ = (int*)(mt_ + MOE_CNT); int* PE_ = (int*)(mt_ + MOE_PANEL); \
    if (IN((P0))) { moe_r1(C, X, in[2] + (LAYER) * D, in[25] + (F) * 8192, in[26] + (F) * 8, XN, TE_, TW_, CNT_); } SEAM((P0)); \
    if (IN((P0) + 1)) { moe_r2(C, XN, TE_, TW_, CNT_, SLOT_, GW_, PE_, XG8); } SEAM((P0) + 1); \
    if (IN((P0) + 2)) { const int np_ = __builtin_amdgcn_readfirstlane(__hip_atomic_load(PE_ + MAXPANEL, __ATOMIC_RELAXED, __HIP_MEMORY_SCOPE_AGENT)); \
        LAS int* peL_ = (LAS int*)(C.lds + RING_BYTES + 8192); if (C.tid < MAXPANEL) peL_[C.tid] = __hip_atomic_load(PE_ + C.tid, __ATOMIC_RELAXED, __HIP_MEMORY_SCOPE_AGENT); __syncthreads(); \
        pg8::Gemm g_{(const pg8::bf16_t*)XG8, (const pg8::bf16_t*)(ws + W_MOE_GU + (size_t)(F) * 8 * SZ_MOE_GU), MAXSLOT, 2 * FFE, D / 2, SZ_MOE_GU, C.wave}; pg8::MoeOrder S_{peL_, np_, 2 * FFE / 256, C.G, C.blk}; \
        pg8::EpiSwiGLU8<0> E_{H8, FFE, 0.015625f, 8.f, nullptr}; pg8::gemm_phase<pg8::EpiSwiGLU8<0>, pg8::MoeOrder, true, true, true>(ring, g_, S_, E_); \
        if constexpr (PROBE == 1 && (F) == 1) { GRID_BAR(); pg8::gemm_phase<pg8::EpiSwiGLU8<0>, pg8::MoeOrder, true, true, true>(ring, g_, S_, E_); } } SEAM((P0) + 2); \
    if (IN((P0) + 3)) { const int np_ = __builtin_amdgcn_readfirstlane(__hip_atomic_load(PE_ + MAXPANEL, __ATOMIC_RELAXED, __HIP_MEMORY_SCOPE_AGENT)); \
        LAS int* peL_ = (LAS int*)(C.lds + RING_BYTES + 8192); if (C.tid < MAXPANEL) peL_[C.tid] = __hip_atomic_load(PE_ + C.tid, __ATOMIC_RELAXED, __HIP_MEMORY_SCOPE_AGENT); __syncthreads(); \
        pg8::Gemm g_{(const pg8::bf16_t*)H8, (const pg8::bf16_t*)(ws + W_MOE_D + (size_t)(F) * 8 * SZ_MOE_D), MAXSLOT, D, FFE / 2, SZ_MOE_D, C.wave}; pg8::MoeOrder S_{peL_, np_, D / 256, C.G, C.blk}; \
        pg8::EpiRowScaleBf16 E_{(pg8::bf16_t*)Yb, D, GW_, 0.001953125f}; pg8::gemm_phase<pg8::EpiRowScaleBf16, pg8::MoeOrder, true, true, true>(ring, g_, S_, E_); \
        if constexpr (PROBE == 2 && (F) == 1) { GRID_BAR(); pg8::gemm_phase<pg8::EpiRowScaleBf16, pg8::MoeOrder, true, true, true>(ring, g_, S_, E_); } \
        if ((F) == 0 && (C.blk & 7) != 0) { REFRESH(); convert_phase(C, in, ws, 2, ((C.blk >> 3) * 7 + (C.blk & 7) - 1) * NWAVES + C.wave, 224 * NWAVES); } } SEAM((P0) + 3); \
    if (IN((P0) + 4)) { combine_phase<FINAL, (S5_FP8 != 0)>(C, X, Yb, SLOT_, (NEXTGAIN), XN, args.out); } SEAM((P0) + 4); \
  } while (0)

    if (IN(0)) { convert_phase(C, in, ws, 0, C.blk * NWAVES + C.wave, C.G * NWAVES); }
#if MK_PER_PHASE
    SEAM(0);
#endif
    ML_LAYER(1, 0, 0, x_in, false);
    DENSE_FFN(7, 0, 0);
#if AT_FP8
    if (IN(11)) { pg8::Gemm g_{(const pg8::bf16_t*)X8, (const pg8::bf16_t*)(ws + W_AT_IN), T, 3072, D / 2, 0, C.wave}; pg8::StaticOrder S_; S_.init(T, 3072, C.G, C.blk);
        pg8::EpiBf16<16> E_{(pg8::bf16_t*)PROJ, 3072, 1024, 0.18033688011112042f * 0.015625f, SSQB, 0.015625f}; pg8::gemm_phase<pg8::EpiBf16<16>, pg8::StaticOrder, true, true, true>(ring, g_, S_, E_); } SEAM(11);
    if (IN(12)) { attn_phase<true>(C, PROJ, in[10], Gb); } SEAM(12);
#else
    if (IN(11)) { pg8::EpiBf16<16> E_{(pg8::bf16_t*)PROJ, 3072, 1024, 0.18033688011112042f, SSQB}; GEMM_DENSE(pg8::EpiBf16<16>, X, ws + W_AT_IN, 3072, D, E_); } SEAM(11);
    if (IN(12)) { attn_phase<false>(C, PROJ, in[10], Gb); } SEAM(12);
#endif
#if AT_FP8
    if (IN(13)) { pg8::Gemm g_{(const pg8::bf16_t*)Gb, (const pg8::bf16_t*)(ws + W_AT_OUT), T, D, D / 2, 0, C.wave}; pg8::StaticOrder S_; S_.init(T, D, C.G, C.blk);
        pg8::EpiRes<false> E_{X, (pg8::bf16_t*)X, D, 0.015625f, nullptr}; pg8::gemm_phase<pg8::EpiRes<false>, pg8::StaticOrder, true, true, true>(ring, g_, S_, E_); } SEAM(13);
#else
    if (IN(13)) { pg8::EpiRes<false> E_{X, (pg8::bf16_t*)X, D, 1.f, nullptr}; GEMM_DENSE(pg8::EpiRes<false>, Gb, ws + W_AT_OUT, D, D, E_); } SEAM(13);
#endif
    MOE_FFN(14, 0, 1, false, in[1] + 2 * D);
#if S5_FP8
    if (IN(19)) { pg8::Gemm g_{(const pg8::bf16_t*)XN, (const pg8::bf16_t*)(ws + W_S5_IN), T, D, D / 2, 0, C.wave}; pg8::StaticOrder S_; S_.init(T, D, C.G, C.blk);
        pg8::EpiF32G E_{U32, T, 0.015625f}; pg8::gemm_phase<pg8::EpiF32G, pg8::StaticOrder, true, true, true>(ring, g_, S_, E_); } SEAM(19);
#else
    if (IN(19)) { pg8::EpiF32G E_{U32, T, 1.f}; GEMM_DENSE(pg8::EpiF32G, XN, ws + W_S5_IN, D, D, E_); } SEAM(19);
#endif
    if (IN(20)) { s5_phase(C, U32, in[13], in[14], in[15], in[16], in[17], in[18], in[19], in[20], Gb); } SEAM(20);
#if S5_FP8
    if (IN(21)) { pg8::Gemm g_{(const pg8::bf16_t*)Gb, (const pg8::bf16_t*)(ws + W_S5_OUT), T, 2 * D, D / 2, 0, C.wave, 16u, (unsigned)T * 16u}; pg8::StaticOrder S_; S_.init(T, 2 * D, C.G, C.blk);
        pg8::EpiGluRes E_{(const pg8::bf16_t*)X, (pg8::bf16_t*)X, D, X8, SSQC, 0.015625f}; pg8::gemm_phase<pg8::EpiGluRes, pg8::StaticOrder, true, true, true>(ring, g_, S_, E_); } SEAM(21);
#else
    if (IN(21)) { pg8::EpiGluRes E_{(const pg8::bf16_t*)X, (pg8::bf16_t*)X, D, X8, SSQC, 1.f}; GEMM_DENSE(pg8::EpiGluRes, Gb, ws + W_S5_OUT, 2 * D, D, E_); } SEAM(21);
#endif
    DENSE_FFN8(22, 1, 2);
    ML_LAYER(25, 1, 3, X, true);
    MOE_FFN(31, 1, 3, true, in[3]);
#undef IN
#undef IN_
#undef SEAM
}
constexpr int NPH = 36;

extern "C" void kernel_launch(void* const* d_in, const int* in_sizes, int n_in, void* d_out, int out_size, void* d_ws, size_t ws_size, hipStream_t stream) {
    static int grid = 0;
    if (grid == 0) {
        if (n_in != 30 || in_sizes[0] != T * D || out_size != T * D || ws_size < WS_END) { fprintf(stderr, "kernel_launch: unexpected problem (n_in %d, in0 %d, out %d, ws %zu < %zu); nothing launched\n", n_in, n_in > 0 ? in_sizes[0] : -1, out_size, ws_size, (size_t)WS_END); grid = -1; return; }
        int dev = 0, cus = 0, per_cu = 0;
        if (hipGetDevice(&dev) != hipSuccess || hipDeviceGetAttribute(&cus, hipDeviceAttributeMultiprocessorCount, dev) != hipSuccess) { fprintf(stderr, "kernel_launch: device query failed\n"); grid = -1; return; }
        if (hipFuncSetAttribute((const void*)fwd_kernel, hipFuncAttributeMaxDynamicSharedMemorySize, LDS_BYTES) != hipSuccess) { fprintf(stderr, "kernel_launch: hipFuncSetAttribute failed\n"); grid = -1; return; }
        if (hipOccupancyMaxActiveBlocksPerMultiprocessor(&per_cu, (const void*)fwd_kernel, NTHR, LDS_BYTES) != hipSuccess || per_cu < 1) fprintf(stderr, "kernel_launch: note: occupancy query reports %d workgroups per CU\n", per_cu);
        (void)hipGetLastError();
        if (cus != 256) { fprintf(stderr, "kernel_launch: built for 256 CUs, device has %d; nothing launched\n", cus); grid = -1; return; }
        grid = 256;
    }
    if (grid < 0) return;
    if (hipMemsetAsync((char*)d_ws + WS_CTL, 0, CTL_ZERO_BYTES, stream) != hipSuccess) { fprintf(stderr, "kernel_launch: memset failed\n"); return; }
    Args a{};
    for (int i = 0; i < 30; ++i) a.in[i] = (const float*)d_in[i];
    a.out = (float*)d_out; a.ws = (unsigned char*)d_ws; a.li = 0; a.pad = 0;
#if MK_PER_PHASE
    for (int p = 0; p < NPH; ++p) { a.ph_lo = p; a.ph_hi = p + 1; hipLaunchKernelGGL(fwd_kernel, dim3(grid), dim3(NTHR), LDS_BYTES, stream, a); }
#else
    a.ph_lo = 0; a.ph_hi = NPH;
    hipLaunchKernelGGL(fwd_kernel, dim3(grid), dim3(NTHR), LDS_BYTES, stream, a);
#endif
    const hipError_t le = hipPeekAtLastError();
    if (le != hipSuccess) fprintf(stderr, "kernel_launch: launch failed: %s\n", hipGetErrorName(le));
}
```
